# Optimizing an MI355X kernel written in HIP

```python
import math
import jax, jax.numpy as jnp
from jax import lax
import numpy as np

D_MODEL = 1024
BATCH = 8
SEQ = 4096
DEPTH = 2

MLSTM_HEADS = 4
MLSTM_HEAD_DIM = D_MODEL // 8
MLSTM_WIDTH = MLSTM_HEADS * MLSTM_HEAD_DIM
MLSTM_CHUNK = 64
MLA_HEADS = 4
MLA_NOPE_DIM = D_MODEL // 8
MLA_ROPE_DIM = 64
MLA_V_DIM = D_MODEL // 8
MLA_Q_LORA = D_MODEL // 4
MLA_KV_LORA = D_MODEL // 8
MLA_WIDTH = MLA_HEADS * MLA_V_DIM
ROPE_THETA = 10000.0
ATTN_BLOCK = 128
POOL_WINDOWS = (2, 4, 8, 16)
POOL_GROUPS = len(POOL_WINDOWS)
POOL_GROUP_DIM = D_MODEL // POOL_GROUPS
FFN_DIM = ((8 * D_MODEL // 3 + 127) // 128) * 128
CONV_WIDTH = 3
LN_EPS = 1e-5
RMS_EPS = 1e-6
DEEPNORM_ALPHA = (2 * DEPTH) ** 0.25
DEEPNORM_BETA = (8 * DEPTH) ** -0.25
N_EVEN = (DEPTH + 1) // 2
N_ODD = DEPTH // 2
IN_SIZES = (MLSTM_WIDTH, MLSTM_WIDTH, MLSTM_WIDTH, MLSTM_WIDTH, MLSTM_HEADS, MLSTM_HEADS,
            MLA_Q_LORA, MLA_KV_LORA, MLA_ROPE_DIM)
IN_COLS = sum(IN_SIZES)

kernel_name = "hybrid_mlstm_mla_pool_deepnorm"


def layer_norm(x, g, b):
    xf = x.astype(jnp.float32)
    mu = jnp.mean(xf, axis=-1, keepdims=True)
    var = jnp.mean(jnp.square(xf - mu), axis=-1, keepdims=True)
    return ((xf - mu) * lax.rsqrt(var + LN_EPS) * g + b).astype(x.dtype)


def rms_norm(x, g):
    xf = x.astype(jnp.float32)
    return (xf * lax.rsqrt(jnp.mean(jnp.square(xf), axis=-1, keepdims=True) + RMS_EPS) * g).astype(x.dtype)


def rope_tables(positions):
    inv_freq = ROPE_THETA ** (-jnp.arange(0, MLA_ROPE_DIM, 2, dtype=jnp.float32) / MLA_ROPE_DIM)
    ang = positions.astype(jnp.float32)[..., None] * inv_freq
    return jnp.cos(ang), jnp.sin(ang)


def apply_rope(x, cos, sin):
    xf = x.astype(jnp.float32)
    x1, x2 = jnp.split(xf, 2, axis=-1)
    return jnp.concatenate([x1 * cos - x2 * sin, x2 * cos + x1 * sin], axis=-1).astype(x.dtype)


def mlstm_chunkwise(q, k, v, i_pre, f_pre):
    B, H, S, d = q.shape
    L = MLSTM_CHUNK
    nc = S // L
    f32 = jnp.float32

    def chunks(t):
        return jnp.moveaxis(t.astype(f32).reshape(B, H, nc, L, *t.shape[3:]), 2, 0)

    qc, kc, vc = chunks(q), chunks(k), chunks(v)
    ic = chunks(i_pre)
    bc = jnp.cumsum(chunks(jax.nn.log_sigmoid(f_pre.astype(f32))), axis=-1)
    causal = jnp.tril(jnp.ones((L, L), dtype=bool))

    def step(carry, xs):
        C, n, m = carry
        q_, k_, v_, i_, b_ = xs
        D = jnp.where(causal, b_[..., :, None] - b_[..., None, :] + i_[..., None, :], -jnp.inf)
        inter = b_ + m[..., None]
        m_t = jnp.maximum(jnp.max(D, axis=-1), inter)
        A = jnp.einsum('bhtk,bhsk->bhts', q_, k_) * jnp.exp(D - m_t[..., None])
        sc = jnp.exp(inter - m_t)
        num = jnp.einsum('bhts,bhsv->bhtv', A, v_) + sc[..., None] * jnp.einsum('bhvk,bhtk->bhtv', C, q_)
        den = jnp.sum(A, axis=-1) + sc * jnp.einsum('bhk,bhtk->bht', n, q_)
        h = num / jnp.maximum(jnp.abs(den), jnp.exp(-m_t))[..., None]
        b_last = b_[..., -1]
        g = b_last[..., None] - b_ + i_
        m_new = jnp.maximum(b_last + m, jnp.max(g, axis=-1))
        w = jnp.exp(g - m_new[..., None])
        decay = jnp.exp(b_last + m - m_new)
        C = decay[..., None, None] * C + jnp.einsum('bhs,bhsv,bhsk->bhvk', w, v_, k_)
        n = decay[..., None] * n + jnp.einsum('bhs,bhsk->bhk', w, k_)
        return (C, n, m_new), h

    init = (jnp.zeros((B, H, d, d), f32), jnp.zeros((B, H, d), f32), jnp.zeros((B, H), f32))
    _, h = lax.scan(step, init, (qc, kc, vc, ic, bc))
    return jnp.moveaxis(h, 0, 2).reshape(B, H, S, d).astype(q.dtype)


def causal_attention_blocked(q, k, v):
    B, H, S, dk = q.shape
    nb = S // ATTN_BLOCK
    scale = dk ** -0.5
    qb = jnp.moveaxis(q.reshape(B, H, nb, ATTN_BLOCK, dk), 2, 0)
    key_pos = jnp.arange(S)

    def one_block(args):
        idx, qblk = args
        s = jnp.einsum('bhqd,bhkd->bhqk', qblk, k, preferred_element_type=jnp.float32) * scale
        q_pos = idx * ATTN_BLOCK + jnp.arange(ATTN_BLOCK)
        mask = key_pos[None, :] <= q_pos[:, None]
        p = jax.nn.softmax(jnp.where(mask, s, -jnp.inf), axis=-1)
        return jnp.einsum('bhqk,bhkd->bhqd', p.astype(v.dtype), v)

    o = lax.map(one_block, (jnp.arange(nb), qb))
    return jnp.moveaxis(o, 0, 2).reshape(B, H, S, v.shape[-1])


def hybrid_mixer(x, cos, sin, w_in, b_igate, b_fgate, mlstm_norm, q_norm, kv_norm, w_uq, w_ukv, w_out):
    B, S, _ = x.shape
    h = x @ w_in
    offs = np.cumsum(IN_SIZES)[:-1].tolist()
    q_m, k_m, v_m, o_m, i_pre, f_pre, c_q, c_kv, k_r = jnp.split(h, offs, axis=-1)

    def heads(t, nh):
        return t.reshape(B, S, nh, -1).transpose(0, 2, 1, 3)

    hm = mlstm_chunkwise(heads(q_m, MLSTM_HEADS),
                         heads(k_m, MLSTM_HEADS) * (MLSTM_HEAD_DIM ** -0.5),
                         heads(v_m, MLSTM_HEADS),
                         (i_pre + b_igate).transpose(0, 2, 1),
                         (f_pre + b_fgate).transpose(0, 2, 1))
    hm = rms_norm(hm.transpose(0, 2, 1, 3), mlstm_norm.reshape(MLSTM_HEADS, MLSTM_HEAD_DIM))
    y_m = (hm * jax.nn.sigmoid(o_m.reshape(B, S, MLSTM_HEADS, MLSTM_HEAD_DIM))).reshape(B, S, MLSTM_WIDTH)

    q = (rms_norm(c_q, q_norm) @ w_uq).reshape(B, S, MLA_HEADS, MLA_NOPE_DIM + MLA_ROPE_DIM)
    q_nope, q_rope = q[..., :MLA_NOPE_DIM], q[..., MLA_NOPE_DIM:]
    q_rope = apply_rope(q_rope, cos[:, :, None, :], sin[:, :, None, :])
    kv = (rms_norm(c_kv, kv_norm) @ w_ukv).reshape(B, S, MLA_HEADS, MLA_NOPE_DIM + MLA_V_DIM)
    k_nope, v = kv[..., :MLA_NOPE_DIM], kv[..., MLA_NOPE_DIM:]
    k_rope = jnp.broadcast_to(apply_rope(k_r, cos, sin)[:, :, None, :], (B, S, MLA_HEADS, MLA_ROPE_DIM))
    qh = jnp.concatenate([q_nope, q_rope], axis=-1).transpose(0, 2, 1, 3)
    kh = jnp.concatenate([k_nope, k_rope], axis=-1).transpose(0, 2, 1, 3)
    y_a = causal_attention_blocked(qh, kh, v.transpose(0, 2, 1, 3))
    y_a = y_a.transpose(0, 2, 1, 3).reshape(B, S, MLA_WIDTH)

    return jnp.concatenate([y_m, y_a], axis=-1) @ w_out


def pool_mixer(x, pool_w, layer_scale):
    B, S, D = x.shape
    xf = x.astype(jnp.float32)
    cs = jnp.concatenate([jnp.zeros((B, 1, D), jnp.float32), jnp.cumsum(xf, axis=1)], axis=1)
    t = jnp.arange(S)
    outs = []
    for g, w in enumerate(POOL_WINDOWS):
        sl = slice(g * POOL_GROUP_DIM, (g + 1) * POOL_GROUP_DIM)
        start = jnp.maximum(t + 1 - w, 0)
        csg = cs[..., sl]
        mean = (csg[:, 1:] - csg[:, start]) / (t + 1 - start).astype(jnp.float32)[:, None]
        outs.append(mean - xf[..., sl])
    pooled = jnp.stack(outs, axis=2).astype(x.dtype)
    y = jnp.einsum('bsgc,gcd->bsgd', pooled, pool_w).reshape(B, S, D)
    return y * layer_scale


def conv_ffn(x, w_up, conv_w, conv_b, w_down):
    S = x.shape[1]
    u = x @ w_up
    up = jnp.pad(u, ((0, 0), (CONV_WIDTH - 1, 0), (0, 0)))
    u = sum(up[:, j:j + S] * conv_w[j] for j in range(CONV_WIDTH)) + conv_b
    gate, val = jnp.split(u, 2, axis=-1)
    return (jax.nn.silu(gate) * val) @ w_down


def setup_inputs(seed: int = 0) -> dict:
    key = jax.random.key(seed)
    ks = jax.random.split(key, 24)
    f32 = jnp.float32

    def nrm(k, shape, scale):
        return jax.random.normal(k, shape, f32) * scale

    x = jax.random.normal(ks[0], (BATCH, SEQ, D_MODEL), f32)
    positions = (jnp.arange(SEQ, dtype=jnp.int32)[None, :]
                 + jax.random.randint(ks[1], (BATCH, 1), 0, 1024, dtype=jnp.int32))
    v_lo = 2 * MLSTM_WIDTH
    even_w_in = nrm(ks[2], (N_EVEN, D_MODEL, IN_COLS), D_MODEL ** -0.5)
    even_w_in = even_w_in.at[..., v_lo:v_lo + MLSTM_WIDTH].multiply(DEEPNORM_BETA)
    even_b_igate = -2.0 + nrm(ks[3], (N_EVEN, MLSTM_HEADS), 0.1)
    even_b_fgate = jnp.linspace(3.0, 6.0, MLSTM_HEADS, dtype=f32)[None] + nrm(ks[4], (N_EVEN, MLSTM_HEADS), 0.1)
    even_mlstm_norm = 1.0 + nrm(ks[5], (N_EVEN, MLSTM_WIDTH), 0.05)
    even_q_norm = 1.0 + nrm(ks[6], (N_EVEN, MLA_Q_LORA), 0.05)
    even_kv_norm = 1.0 + nrm(ks[7], (N_EVEN, MLA_KV_LORA), 0.05)
    even_w_uq = nrm(ks[8], (N_EVEN, MLA_Q_LORA, MLA_HEADS * (MLA_NOPE_DIM + MLA_ROPE_DIM)), MLA_Q_LORA ** -0.5)
    w_ukv = nrm(ks[9], (N_EVEN, MLA_KV_LORA, MLA_HEADS, MLA_NOPE_DIM + MLA_V_DIM), MLA_KV_LORA ** -0.5)
    even_w_ukv = w_ukv.at[..., MLA_NOPE_DIM:].multiply(DEEPNORM_BETA).reshape(N_EVEN, MLA_KV_LORA, -1)
    even_w_out = nrm(ks[10], (N_EVEN, MLSTM_WIDTH + MLA_WIDTH, D_MODEL), DEEPNORM_BETA * (MLSTM_WIDTH + MLA_WIDTH) ** -0.5)
    odd_pool_w = nrm(ks[11], (N_ODD, POOL_GROUPS, POOL_GROUP_DIM, POOL_GROUP_DIM), DEEPNORM_BETA * POOL_GROUP_DIM ** -0.5)
    odd_layer_scale = 1.0 + nrm(ks[12], (N_ODD, D_MODEL), 0.1)
    ffn_w_up = nrm(ks[13], (DEPTH, D_MODEL, 2 * FFN_DIM), DEEPNORM_BETA * D_MODEL ** -0.5)
    ffn_conv_w = nrm(ks[14], (DEPTH, CONV_WIDTH, 2 * FFN_DIM), CONV_WIDTH ** -0.5)
    ffn_conv_b = nrm(ks[15], (DEPTH, 2 * FFN_DIM), 0.02)
    ffn_w_down = nrm(ks[16], (DEPTH, FFN_DIM, D_MODEL), DEEPNORM_BETA * FFN_DIM ** -0.5)
    ln_mix_g = 1.0 + nrm(ks[17], (DEPTH, D_MODEL), 0.05)
    ln_mix_b = nrm(ks[18], (DEPTH, D_MODEL), 0.02)
    ln_ffn_g = 1.0 + nrm(ks[19], (DEPTH, D_MODEL), 0.05)
    ln_ffn_b = nrm(ks[20], (DEPTH, D_MODEL), 0.02)
    return {"x": x, "positions": positions,
            "even_w_in": even_w_in, "even_b_igate": even_b_igate, "even_b_fgate": even_b_fgate,
            "even_mlstm_norm": even_mlstm_norm, "even_q_norm": even_q_norm, "even_kv_norm": even_kv_norm,
            "even_w_uq": even_w_uq, "even_w_ukv": even_w_ukv, "even_w_out": even_w_out,
            "odd_pool_w": odd_pool_w, "odd_layer_scale": odd_layer_scale,
            "ffn_w_up": ffn_w_up, "ffn_conv_w": ffn_conv_w, "ffn_conv_b": ffn_conv_b, "ffn_w_down": ffn_w_down,
            "ln_mix_g": ln_mix_g, "ln_mix_b": ln_mix_b, "ln_ffn_g": ln_ffn_g, "ln_ffn_b": ln_ffn_b}


def reference(x, positions, even_w_in, even_b_igate, even_b_fgate, even_mlstm_norm, even_q_norm,
              even_kv_norm, even_w_uq, even_w_ukv, even_w_out, odd_pool_w, odd_layer_scale,
              ffn_w_up, ffn_conv_w, ffn_conv_b, ffn_w_down, ln_mix_g, ln_mix_b, ln_ffn_g, ln_ffn_b):
    cos, sin = rope_tables(positions)
    for layer in range(DEPTH):
        e = layer // 2
        if layer % 2 == 0:
            y = hybrid_mixer(x, cos, sin, even_w_in[e], even_b_igate[e], even_b_fgate[e],
                             even_mlstm_norm[e], even_q_norm[e], even_kv_norm[e],
                             even_w_uq[e], even_w_ukv[e], even_w_out[e])
        else:
            y = pool_mixer(x, odd_pool_w[e], odd_layer_scale[e])
        x = layer_norm(DEEPNORM_ALPHA * x + y, ln_mix_g[layer], ln_mix_b[layer])
        y = conv_ffn(x, ffn_w_up[layer], ffn_conv_w[layer], ffn_conv_b[layer], ffn_w_down[layer])
        x = layer_norm(DEEPNORM_ALPHA * x + y, ln_ffn_g[layer], ln_ffn_b[layer])
    return x
```

```cpp
#include <hip/hip_runtime.h>
#include <cstdio>
#include <cstdint>

typedef unsigned short bf16_t;
typedef short bf16x8 __attribute__((ext_vector_type(8)));
typedef float f32x4 __attribute__((ext_vector_type(4)));

constexpr int NB = 8, SEQ = 4096, DM = 1024, T = NB * SEQ;
constexpr int IN_COLS = 2504, NIN = 2560;
constexpr int FF = 2816, FF2 = 5632;
constexpr float ALPHA = 1.4142135623730951f;
constexpr float LN_EPS = 1e-5f, RMS_EPS = 1e-6f;

constexpr size_t MiB = 1u << 20;
constexpr size_t WS_WIN = 0, WS_WUQ = 5 * MiB, WS_WUKV = 6 * MiB, WS_WOUT = 7 * MiB, WS_WPOOL = 9 * MiB, WS_WUP = 10 * MiB, WS_WDN = 32 * MiB;
constexpr size_t WS_CTL = 44 * MiB, WS_COS = 46 * MiB, WS_SIN = 50 * MiB, WS_GI = 54 * MiB, WS_GF = 54 * MiB + 512 * 1024, WS_SSQ = 55 * MiB;
constexpr size_t WS_KR = 56 * MiB, WS_CKV = 60 * MiB, WS_CQ = 68 * MiB, WS_XNB = 84 * MiB, WS_H1 = 148 * MiB, WS_KVB = 276 * MiB, WS_QA = 340 * MiB, WS_Y = 388 * MiB;
constexpr size_t WS_HS = 388 * MiB;
constexpr size_t WS_YS_A = 148 * MiB;
constexpr size_t WS_G = 148 * MiB;
constexpr size_t WS_UH = 324 * MiB;
constexpr size_t WS_YS_B = 324 * MiB;
constexpr size_t WS_PB = 148 * MiB;
constexpr size_t WS_YS_C = 212 * MiB;
constexpr size_t WS_END = 512 * MiB;

__device__ __forceinline__ unsigned f2bf(float f) { unsigned u = __builtin_bit_cast(unsigned, f); return (u + 0x7fffu + ((u >> 16) & 1u)) >> 16; }
__device__ __forceinline__ float bf2f(bf16_t b) { return __builtin_bit_cast(float, ((unsigned)b) << 16); }
__device__ __forceinline__ float wave_sum(float v) {
#pragma unroll
    for (int o = 1; o < 64; o <<= 1) v += __shfl_xor(v, o);
    return v;
}
__device__ __forceinline__ float sigmoidf_(float x) { return 1.f / (1.f + __expf(-x)); }

__host__ __device__ __forceinline__ int rope_dim_of_slot(int p) { const int g = p >> 3, i = p & 7; return (i < 4) ? (4 * g + i) : (32 + 4 * g + (i - 4)); }

__global__ void k_prep_win(const float* __restrict__ w, bf16_t* __restrict__ dst) {
    const size_t idx = (size_t)blockIdx.x * blockDim.x + threadIdx.x; if (idx >= (size_t)NIN * DM) return;
    const int n = (int)(idx / DM), k = (int)(idx % DM);
    int oc = -1; float sc = 1.f;
    if (n < 2048) { oc = n; if (n >= 512 && n < 1024) sc = 0.08838834764831845f; }
    else if (n < 2304) oc = 2056 + (n - 2048);
    else if (n < 2432) oc = 2312 + (n - 2304);
    else if (n < 2496) oc = 2440 + rope_dim_of_slot(n - 2432);
    else if (n < 2500) oc = 2048 + (n - 2496);
    else if (n < 2504) oc = 2052 + (n - 2500);
    const float v = (oc >= 0) ? w[(size_t)k * IN_COLS + oc] * sc : 0.f;
    dst[idx] = (bf16_t)f2bf(v);
}
__global__ void k_prep_wuq(const float* __restrict__ w, const float* __restrict__ g, bf16_t* __restrict__ dst) {
    const int idx = blockIdx.x * blockDim.x + threadIdx.x; if (idx >= 768 * 256) return;
    const int n = idx / 256, k = idx % 256, h = n / 192, d = n % 192;
    const int oc = h * 192 + (d < 128 ? d : 128 + rope_dim_of_slot(d - 128));
    dst[idx] = (bf16_t)f2bf(w[(size_t)k * 768 + oc] * g[k]);
}
__global__ void k_prep_wukv(const float* __restrict__ w, const float* __restrict__ g, bf16_t* __restrict__ dst) {
    const int idx = blockIdx.x * blockDim.x + threadIdx.x; if (idx >= 1024 * 128) return;
    const int n = idx / 128, k = idx % 128;
    dst[idx] = (bf16_t)f2bf(w[(size_t)k * 1024 + n] * g[k]);
}
__global__ void k_prep_tr(const float* __restrict__ w, bf16_t* __restrict__ dst, int K, int N) {
    const size_t idx = (size_t)blockIdx.x * blockDim.x + threadIdx.x; if (idx >= (size_t)K * N) return;
    const int n = (int)(idx / K), k = (int)(idx % K);
    dst[idx] = (bf16_t)f2bf(w[(size_t)k * N + n]);
}
__global__ void k_prep_wup(const float* __restrict__ w, bf16_t* __restrict__ dst) {
    const size_t idx = (size_t)blockIdx.x * blockDim.x + threadIdx.x; if (idx >= (size_t)FF2 * DM) return;
    const int p = (int)(idx / DM), k = (int)(idx % DM);
    const int pn = p >> 8, r = p & 255, oc = ((r >> 7) ? FF : 0) + 128 * pn + (r & 127);
    dst[idx] = (bf16_t)f2bf(w[(size_t)k * FF2 + oc]);
}
__global__ void k_prep_x(const float* __restrict__ x, bf16_t* __restrict__ xb) {
    const size_t idx = (size_t)blockIdx.x * blockDim.x + threadIdx.x; if (idx >= (size_t)T * DM / 4) return;
    const f32x4 v = ((const f32x4*)x)[idx];
    uint2 o; o.x = f2bf(v[0]) | (f2bf(v[1]) << 16); o.y = f2bf(v[2]) | (f2bf(v[3]) << 16);
    ((uint2*)xb)[idx] = o;
}
__device__ __forceinline__ void sincos_reduced(double r, double& s, double& c) {
    const double r2 = r * r;
    double ss = 1.0, cc = 1.0;
#pragma unroll
    for (int n = 27; n >= 3; n -= 2) ss = 1.0 - ss * r2 / (double)((n) * (n - 1));
#pragma unroll
    for (int n = 26; n >= 2; n -= 2) cc = 1.0 - cc * r2 / (double)((n) * (n - 1));
    s = r * ss; c = cc;
}
__global__ void k_prep_rope(const int* __restrict__ pos, float* __restrict__ cs, float* __restrict__ sn) {
    const int idx = blockIdx.x * blockDim.x + threadIdx.x; if (idx >= T * 32) return;
    const int t = idx >> 5, r = idx & 31;
    const float inv_freq = (float)pow(10000.0, -(double)r / 32.0);
    const float ang = (float)pos[t] * inv_freq;
    const double a = (double)ang;
    const double n = rint(a * 0.15915494309189535);
    double rr = fma(-n, 6.283185307179586, a); rr = fma(-n, 2.4492935982947064e-16, rr);
    double s, c; sincos_reduced(rr, s, c);
    cs[idx] = (float)c; sn[idx] = (float)s;
}

template <class Epi>
__global__ __launch_bounds__(256) void k_sgemm(const bf16_t* __restrict__ A, const bf16_t* __restrict__ Bt, Epi epi, int lda, int ldb, int M, int N, int K, int pad_) {
    const int wid = threadIdx.x >> 6, lane = threadIdx.x & 63, fr = lane & 15, fq = lane >> 4;
    const int nbn = N / 128, bm = blockIdx.x / nbn, bn = blockIdx.x % nbn;
    const int r0 = bm * 128 + (wid >> 1) * 64, c0 = bn * 128 + (wid & 1) * 64;
    f32x4 acc[4][4];
#pragma unroll
    for (int i = 0; i < 4; ++i)
#pragma unroll
        for (int j = 0; j < 4; ++j) acc[i][j] = (f32x4){0.f, 0.f, 0.f, 0.f};
    const bf16_t* ap = A + (size_t)(r0 + fr) * lda + fq * 8;
    const bf16_t* bp = Bt + (size_t)(c0 + fr) * ldb + fq * 8;
    for (int k0 = 0; k0 < K; k0 += 32) {
        bf16x8 a[4], b[4];
#pragma unroll
        for (int i = 0; i < 4; ++i) { a[i] = *(const bf16x8*)(ap + (size_t)(16 * i) * lda + k0); b[i] = *(const bf16x8*)(bp + (size_t)(16 * i) * ldb + k0); }
#pragma unroll
        for (int mi = 0; mi < 4; ++mi)
#pragma unroll
            for (int ni = 0; ni < 4; ++ni) acc[mi][ni] = __builtin_amdgcn_mfma_f32_16x16x32_bf16(a[mi], b[ni], acc[mi][ni], 0, 0, 0);
    }
#pragma unroll
    for (int mi = 0; mi < 4; ++mi)
#pragma unroll
        for (int ni = 0; ni < 4; ++ni)
#pragma unroll
            for (int j = 0; j < 4; ++j) epi(r0 + 16 * mi + 4 * fq + j, c0 + 16 * ni + fr, acc[mi][ni][j]);
}
struct EpiWin { bf16_t* H1; float* Hs; __device__ void operator()(int r, int c, float v) const { if (c < 2048) H1[(size_t)r * 2048 + c] = (bf16_t)f2bf(v); else Hs[(size_t)r * 512 + (c - 2048)] = v; } };
struct EpiRs { bf16_t* O; const float* ssq; int ldo; int which; float inv_n; int pad; __device__ void operator()(int r, int c, float v) const {
    const float* s = ssq + (size_t)r * 8 + which * 4; const float rs = rsqrtf(((s[0] + s[1]) + (s[2] + s[3])) * inv_n + RMS_EPS); O[(size_t)r * ldo + c] = (bf16_t)f2bf(v * rs); } };
struct EpiF32 { float* O; const float* cscale; int ldo; int coff; __device__ void operator()(int r, int c, float v) const { O[(size_t)r * ldo + coff + c] = cscale ? v * cscale[coff + c] : v; } };
struct EpiB16 { bf16_t* O; int ldo; int pad; __device__ void operator()(int r, int c, float v) const { O[(size_t)r * ldo + c] = (bf16_t)f2bf(v); } };

__global__ __launch_bounds__(256) void k_rowpass(const float* __restrict__ Hs, const float* __restrict__ cs, const float* __restrict__ sn, const float* __restrict__ b_i, const float* __restrict__ b_f,
                                               bf16_t* __restrict__ CQ, bf16_t* __restrict__ CKV, bf16_t* __restrict__ KR, float* __restrict__ SSQ, float* __restrict__ GI, float* __restrict__ GF) {
    const int row = blockIdx.x * 4 + (threadIdx.x >> 6), lane = threadIdx.x & 63; if (row >= T) return;
    const float* h = Hs + (size_t)row * 512;
    const f32x4 q = *(const f32x4*)(h + lane * 4);
    float sq = (q[0] * q[0] + q[1] * q[1]) + (q[2] * q[2] + q[3] * q[3]); sq = wave_sum(sq);
    { uint2 o; o.x = f2bf(q[0]) | (f2bf(q[1]) << 16); o.y = f2bf(q[2]) | (f2bf(q[3]) << 16); *(uint2*)(CQ + (size_t)row * 256 + lane * 4) = o; }
    float sk = 0.f;
    if (lane < 32) { const f32x4 kv = *(const f32x4*)(h + 256 + lane * 4); sk = (kv[0] * kv[0] + kv[1] * kv[1]) + (kv[2] * kv[2] + kv[3] * kv[3]);
        uint2 o; o.x = f2bf(kv[0]) | (f2bf(kv[1]) << 16); o.y = f2bf(kv[2]) | (f2bf(kv[3]) << 16); *(uint2*)(CKV + (size_t)row * 128 + lane * 4) = o; }
    sk = wave_sum(sk);
    if (lane < 8) SSQ[(size_t)row * 8 + lane] = (lane == 0) ? sq : (lane == 4 ? sk : 0.f);
    if (lane < 32) { const int r = lane, g = r >> 2, i = r & 3; const float x1 = h[384 + 8 * g + i], x2 = h[384 + 8 * g + 4 + i], c = cs[(size_t)row * 32 + r], s = sn[(size_t)row * 32 + r];
        KR[(size_t)row * 64 + 8 * g + i] = (bf16_t)f2bf(x1 * c - x2 * s); KR[(size_t)row * 64 + 8 * g + 4 + i] = (bf16_t)f2bf(x2 * c + x1 * s); }
    if (lane < 4) { GI[(size_t)row * 4 + lane] = h[448 + lane] + b_i[lane]; GF[(size_t)row * 4 + lane] = h[452 + lane] + b_f[lane]; }
}
__global__ void k_rope_q(bf16_t* __restrict__ QA, const float* __restrict__ cs, const float* __restrict__ sn) {
    const int idx = blockIdx.x * blockDim.x + threadIdx.x; if (idx >= T * 4 * 32) return;
    const int row = idx >> 7, h = (idx >> 5) & 3, r = idx & 31, g = r >> 2, i = r & 3;
    bf16_t* p = QA + (size_t)row * 768 + h * 192 + 128 + 8 * g + i;
    const float x1 = bf2f(p[0]), x2 = bf2f(p[4]), c = cs[(size_t)row * 32 + r], s = sn[(size_t)row * 32 + r];
    p[0] = (bf16_t)f2bf(x1 * c - x2 * s); p[4] = (bf16_t)f2bf(x2 * c + x1 * s);
}

__global__ __launch_bounds__(256) void k_attn_naive(const bf16_t* __restrict__ QA, const bf16_t* __restrict__ KVB, const bf16_t* __restrict__ KR, bf16_t* __restrict__ Y) {
    __shared__ unsigned Kt[64][97];
    __shared__ unsigned Vt[64][65];
    const int qblk = blockIdx.x % (SEQ / 64), bh = blockIdx.x / (SEQ / 64), b = bh >> 2, h = bh & 3;
    const int tid = threadIdx.x, qi = tid >> 2, part = tid & 3;
    const int qpos = qblk * 64 + qi; const size_t qrow = (size_t)b * SEQ + qpos;
    float q[48];
#pragma unroll
    for (int i = 0; i < 48; ++i) q[i] = bf2f(QA[qrow * 768 + h * 192 + part * 48 + i]);
    float o[32];
#pragma unroll
    for (int i = 0; i < 32; ++i) o[i] = 0.f;
    float m = -1e30f, l = 0.f;
    const float scale = 0.07216878364870322f;
    for (int kt = 0; kt <= qblk; ++kt) {
        __syncthreads();
        for (int e = tid; e < 64 * 96; e += 256) { const int j = e / 96, c = e % 96; const size_t krow = (size_t)b * SEQ + kt * 64 + j;
            unsigned v; if (c < 64) v = *(const unsigned*)(KVB + krow * 1024 + h * 256 + 2 * c); else v = *(const unsigned*)(KR + krow * 64 + 2 * (c - 64)); Kt[j][c] = v; }
        for (int e = tid; e < 64 * 64; e += 256) { const int j = e / 64, c = e % 64; const size_t krow = (size_t)b * SEQ + kt * 64 + j; Vt[j][c] = *(const unsigned*)(KVB + krow * 1024 + h * 256 + 128 + 2 * c); }
        __syncthreads();
        for (int j = 0; j < 64; ++j) {
            float s = 0.f;
#pragma unroll
            for (int i = 0; i < 24; ++i) { const unsigned w = Kt[j][part * 24 + i]; s += q[2 * i] * __builtin_bit_cast(float, w << 16) + q[2 * i + 1] * __builtin_bit_cast(float, w & 0xffff0000u); }
            s += __shfl_xor(s, 1); s += __shfl_xor(s, 2);
            s *= scale;
            if (kt * 64 + j > qpos) s = -__builtin_inff();
            const float mn = fmaxf(m, s), al = __expf(m - mn), p = __expf(s - mn);
            l = l * al + p; m = mn;
#pragma unroll
            for (int i = 0; i < 16; ++i) { const unsigned w = Vt[j][part * 16 + i]; o[2 * i] = o[2 * i] * al + p * __builtin_bit_cast(float, w << 16); o[2 * i + 1] = o[2 * i + 1] * al + p * __builtin_bit_cast(float, w & 0xffff0000u); }
        }
    }
    const float il = 1.f / l;
#pragma unroll
    for (int i = 0; i < 32; ++i) Y[qrow * 1024 + 512 + h * 128 + part * 32 + i] = (bf16_t)f2bf(o[i] * il);
}

__global__ __launch_bounds__(256) void k_mlstm_naive(const bf16_t* __restrict__ H1, const float* __restrict__ GI, const float* __restrict__ GF, const float* __restrict__ nw, bf16_t* __restrict__ Y) {
    __shared__ float qs[128], ks[128], vs[128], red[8];
    const int b = blockIdx.x >> 2, h = blockIdx.x & 3, tid = threadIdx.x, v = tid >> 1, kh = tid & 1, wid = tid >> 6, lane = tid & 63;
    float C[64];
#pragma unroll
    for (int i = 0; i < 64; ++i) C[i] = 0.f;
    float n = 0.f;
    const float gw = nw[h * 128 + v];
    for (int s = 0; s < SEQ; ++s) {
        const size_t row = (size_t)b * SEQ + s;
        if (tid < 128) { qs[tid] = bf2f(H1[row * 2048 + h * 128 + tid]); ks[tid] = bf2f(H1[row * 2048 + 512 + h * 128 + tid]); vs[tid] = bf2f(H1[row * 2048 + 1024 + h * 128 + tid]); }
        const float ig = __expf(GI[row * 4 + h]), fg = sigmoidf_(GF[row * 4 + h]);
        __syncthreads();
        const float vv = vs[v] * ig; float acc = 0.f;
#pragma unroll
        for (int i = 0; i < 64; ++i) { C[i] = fg * C[i] + vv * ks[64 * kh + i]; acc += C[i] * qs[64 * kh + i]; }
        acc += __shfl_xor(acc, 1);
        float dp = 0.f;
        if (tid < 128) { n = fg * n + ig * ks[tid]; dp = n * qs[tid]; }
        dp = wave_sum(dp);
        if (lane == 0) red[wid] = dp;
        __syncthreads();
        const float den = red[0] + red[1];
        const float hv = acc / fmaxf(fabsf(den), 1.f);
        float sq = (kh == 0) ? hv * hv : 0.f; sq = wave_sum(sq);
        if (lane == 0) red[4 + wid] = sq;
        __syncthreads();
        const float rs = rsqrtf(((red[4] + red[5]) + (red[6] + red[7])) * (1.f / 128.f) + RMS_EPS);
        if (kh == 0) { const float og = sigmoidf_(bf2f(H1[row * 2048 + 1536 + h * 128 + v])); Y[row * 1024 + h * 128 + v] = (bf16_t)f2bf(hv * rs * gw * og); }
    }
}

__global__ __launch_bounds__(256) void k_ln(const float* xin, const float* __restrict__ ys, const float* __restrict__ g, const float* __restrict__ bta, float* out, bf16_t* __restrict__ outb) {
    const int row = blockIdx.x * 4 + (threadIdx.x >> 6), lane = threadIdx.x & 63; if (row >= T) return;
    f32x4 v[4]; float s = 0.f;
#pragma unroll
    for (int j = 0; j < 4; ++j) { const f32x4 a = *(const f32x4*)(xin + (size_t)row * DM + j * 256 + lane * 4), y = *(const f32x4*)(ys + (size_t)row * DM + j * 256 + lane * 4); v[j] = a * ALPHA + y; s += (v[j][0] + v[j][1]) + (v[j][2] + v[j][3]); }
    const float mean = wave_sum(s) * (1.f / DM); float s2 = 0.f;
#pragma unroll
    for (int j = 0; j < 4; ++j) { v[j] = v[j] - mean; s2 += (v[j][0] * v[j][0] + v[j][1] * v[j][1]) + (v[j][2] * v[j][2] + v[j][3] * v[j][3]); }
    const float rstd = rsqrtf(wave_sum(s2) * (1.f / DM) + LN_EPS);
#pragma unroll
    for (int j = 0; j < 4; ++j) { const int c = j * 256 + lane * 4; const f32x4 gg = *(const f32x4*)(g + c), bb = *(const f32x4*)(bta + c); const f32x4 o = v[j] * rstd * gg + bb;
        *(f32x4*)(out + (size_t)row * DM + c) = o; uint2 w; w.x = f2bf(o[0]) | (f2bf(o[1]) << 16); w.y = f2bf(o[2]) | (f2bf(o[3]) << 16); *(uint2*)(outb + (size_t)row * DM + c) = w; }
}

__global__ void k_convact(const bf16_t* __restrict__ U, const float* __restrict__ cw, const float* __restrict__ cb, bf16_t* __restrict__ G, int row0, int pad_) {
    const size_t idx = (size_t)blockIdx.x * blockDim.x + threadIdx.x; if (idx >= (size_t)(T / 2) * FF) return;
    const int rl = (int)(idx / FF), c = (int)(idx % FF), row = row0 + rl, s = row % SEQ;
    const int pg = 256 * (c >> 7) + (c & 127), pv = pg + 128;
    float gate = cb[c], val = cb[FF + c];
#pragma unroll
    for (int j = 0; j < 3; ++j) { const int d = 2 - j; if (s - d >= 0) { gate += cw[j * FF2 + c] * bf2f(U[(size_t)(rl - d) * FF2 + pg]); val += cw[j * FF2 + FF + c] * bf2f(U[(size_t)(rl - d) * FF2 + pv]); } }
    G[(size_t)row * FF + c] = (bf16_t)f2bf(gate * sigmoidf_(gate) * val);
}
__global__ void k_pool(const float* __restrict__ X, bf16_t* __restrict__ PB) {
    const size_t idx = (size_t)blockIdx.x * blockDim.x + threadIdx.x; if (idx >= (size_t)T * DM) return;
    const int row = (int)(idx / DM), ch = (int)(idx % DM), s = row % SEQ, w = 2 << (ch >> 8), cnt = (s + 1 < w) ? s + 1 : w;
    float sum = 0.f; for (int j = 0; j < cnt; ++j) sum += X[(size_t)(row - j) * DM + ch];
    PB[idx] = (bf16_t)f2bf(sum / (float)cnt - X[idx]);
}

template <class Epi> static void sgemm(const bf16_t* A, int lda, const bf16_t* Bt, int ldb, int M, int N, int K, Epi e, hipStream_t st) {
    k_sgemm<Epi><<<dim3((M / 128) * (N / 128)), dim3(256), 0, st>>>(A, Bt, e, lda, ldb, M, N, K, 0);
}
extern "C" void kernel_launch(void* const* d_in, const int* in_sizes, int n_in, void* d_out, int out_size, void* d_ws, size_t ws_size, hipStream_t stream) {
    if (n_in != 21 || in_sizes[0] != T * DM || out_size != T * DM || ws_size < WS_END) { fprintf(stderr, "kernel_launch: unexpected shapes (n_in %d, in0 %d, out %d, ws %zu)\n", n_in, n_in > 0 ? in_sizes[0] : -1, out_size, ws_size); return; }
    const float* x = (const float*)d_in[0]; const int* pos = (const int*)d_in[1];
    const float *w_in = (const float*)d_in[2], *b_ig = (const float*)d_in[3], *b_fg = (const float*)d_in[4], *mnorm = (const float*)d_in[5], *qnorm = (const float*)d_in[6], *kvnorm = (const float*)d_in[7];
    const float *w_uq = (const float*)d_in[8], *w_ukv = (const float*)d_in[9], *w_out = (const float*)d_in[10], *pool_w = (const float*)d_in[11], *lscale = (const float*)d_in[12];
    const float *w_up = (const float*)d_in[13], *conv_w = (const float*)d_in[14], *conv_b = (const float*)d_in[15], *w_dn = (const float*)d_in[16];
    const float *ln_mix_g = (const float*)d_in[17], *ln_mix_b = (const float*)d_in[18], *ln_ffn_g = (const float*)d_in[19], *ln_ffn_b = (const float*)d_in[20];
    float* out = (float*)d_out; unsigned char* ws = (unsigned char*)d_ws;
    bf16_t *Win_t = (bf16_t*)(ws + WS_WIN), *Wuq_t = (bf16_t*)(ws + WS_WUQ), *Wukv_t = (bf16_t*)(ws + WS_WUKV), *Wout_t = (bf16_t*)(ws + WS_WOUT), *Wpool_t = (bf16_t*)(ws + WS_WPOOL), *Wup_t = (bf16_t*)(ws + WS_WUP), *Wdn_t = (bf16_t*)(ws + WS_WDN);
    float *COS = (float*)(ws + WS_COS), *SIN = (float*)(ws + WS_SIN), *GI = (float*)(ws + WS_GI), *GF = (float*)(ws + WS_GF), *SSQ = (float*)(ws + WS_SSQ);
    bf16_t *KR = (bf16_t*)(ws + WS_KR), *CKV = (bf16_t*)(ws + WS_CKV), *CQ = (bf16_t*)(ws + WS_CQ), *XNB = (bf16_t*)(ws + WS_XNB), *H1 = (bf16_t*)(ws + WS_H1), *KVB = (bf16_t*)(ws + WS_KVB), *QA = (bf16_t*)(ws + WS_QA), *Y = (bf16_t*)(ws + WS_Y);
    float* Hs = (float*)(ws + WS_HS);
    auto nblk = [](size_t n, int b) { return dim3((unsigned)((n + b - 1) / b)); };
    k_prep_win<<<nblk((size_t)NIN * DM, 256), 256, 0, stream>>>(w_in, Win_t);
    k_prep_wuq<<<nblk(768 * 256, 256), 256, 0, stream>>>(w_uq, qnorm, Wuq_t);
    k_prep_wukv<<<nblk(1024 * 128, 256), 256, 0, stream>>>(w_ukv, kvnorm, Wukv_t);
    k_prep_tr<<<nblk((size_t)DM * DM, 256), 256, 0, stream>>>(w_out, Wout_t, DM, DM);
    for (int g = 0; g < 4; ++g) k_prep_tr<<<nblk(256 * 256, 256), 256, 0, stream>>>(pool_w + (size_t)g * 65536, Wpool_t + (size_t)g * 65536, 256, 256);
    for (int l = 0; l < 2; ++l) { k_prep_wup<<<nblk((size_t)FF2 * DM, 256), 256, 0, stream>>>(w_up + (size_t)l * DM * FF2, Wup_t + (size_t)l * FF2 * DM);
        k_prep_tr<<<nblk((size_t)FF * DM, 256), 256, 0, stream>>>(w_dn + (size_t)l * FF * DM, Wdn_t + (size_t)l * DM * FF, FF, DM); }
    k_prep_x<<<nblk((size_t)T * DM / 4, 256), 256, 0, stream>>>(x, XNB);
    k_prep_rope<<<nblk((size_t)T * 32, 256), 256, 0, stream>>>(pos, COS, SIN);
    sgemm(XNB, DM, Win_t, DM, T, NIN, DM, EpiWin{H1, Hs}, stream);
    k_rowpass<<<dim3(T / 4), 256, 0, stream>>>(Hs, COS, SIN, b_ig, b_fg, CQ, CKV, KR, SSQ, GI, GF);
    sgemm(CQ, 256, Wuq_t, 256, T, 768, 256, EpiRs{QA, SSQ, 768, 0, 1.f / 256.f, 0}, stream);
    k_rope_q<<<nblk((size_t)T * 128, 256), 256, 0, stream>>>(QA, COS, SIN);
    sgemm(CKV, 128, Wukv_t, 128, T, 1024, 128, EpiRs{KVB, SSQ, 1024, 1, 1.f / 128.f, 0}, stream);
    k_attn_naive<<<dim3(NB * 4 * (SEQ / 64)), 256, 0, stream>>>(QA, KVB, KR, Y);
    k_mlstm_naive<<<dim3(NB * 4), 256, 0, stream>>>(H1, GI, GF, mnorm, Y);
    { float* Ys = (float*)(ws + WS_YS_A); sgemm(Y, DM, Wout_t, DM, T, DM, DM, EpiF32{Ys, nullptr, DM, 0}, stream);
      k_ln<<<dim3(T / 4), 256, 0, stream>>>(x, Ys, ln_mix_g, ln_mix_b, out, XNB); }
    for (int l = 0; l < 2; ++l) {
        if (l == 1) {
            bf16_t* PB = (bf16_t*)(ws + WS_PB); float* Ys = (float*)(ws + WS_YS_C);
            k_pool<<<nblk((size_t)T * DM, 256), 256, 0, stream>>>(out, PB);
            for (int g = 0; g < 4; ++g) sgemm(PB + 256 * g, DM, Wpool_t + (size_t)g * 65536, 256, T, 256, 256, EpiF32{Ys, lscale, DM, 256 * g}, stream);
            k_ln<<<dim3(T / 4), 256, 0, stream>>>(out, Ys, ln_mix_g + DM, ln_mix_b + DM, out, XNB);
        }
        bf16_t* G = (bf16_t*)(ws + WS_G); bf16_t* Uh = (bf16_t*)(ws + WS_UH); float* Ys = (float*)(ws + WS_YS_B);
        for (int half = 0; half < 2; ++half) {
            sgemm(XNB + (size_t)half * (T / 2) * DM, DM, Wup_t + (size_t)l * FF2 * DM, DM, T / 2, FF2, DM, EpiB16{Uh, FF2, 0}, stream);
            k_convact<<<nblk((size_t)(T / 2) * FF, 256), 256, 0, stream>>>(Uh, conv_w + (size_t)l * 3 * FF2, conv_b + (size_t)l * FF2, G, half * (T / 2), 0);
        }
        sgemm(G, FF, Wdn_t + (size_t)l * DM * FF, FF, T, DM, FF, EpiF32{Ys, nullptr, DM, 0}, stream);
        k_ln<<<dim3(T / 4), 256, 0, stream>>>(out, Ys, ln_ffn_g + (size_t)l * DM, ln_ffn_b + (size_t)l * DM, out, XNB);
    }
}
```

```cpp
#include <hip/hip_runtime.h>
#include <cstdio>
#include <cstdint>

typedef unsigned short bf16_t;
typedef short bf16x8 __attribute__((ext_vector_type(8)));
typedef float f32x4 __attribute__((ext_vector_type(4)));

constexpr int NB = 8, SEQ = 4096, DM = 1024, T = NB * SEQ;
constexpr int IN_COLS = 2504, NIN = 2560;
constexpr int FF = 2816, FF2 = 5632;
constexpr float ALPHA = 1.4142135623730951f;
constexpr float LN_EPS = 1e-5f, RMS_EPS = 1e-6f;

constexpr size_t MiB = 1u << 20;
constexpr size_t WS_WIN = 0, WS_WUQ = 5 * MiB, WS_WUKV = 6 * MiB, WS_WOUT = 7 * MiB, WS_WPOOL = 9 * MiB, WS_WUP = 10 * MiB, WS_WDN = 32 * MiB;
constexpr size_t WS_CTL = 44 * MiB, WS_COS = 46 * MiB, WS_SIN = 50 * MiB, WS_GI = 54 * MiB, WS_GF = 54 * MiB + 512 * 1024, WS_SSQ = 55 * MiB;
constexpr size_t WS_KR = 56 * MiB, WS_CKV = 60 * MiB, WS_CQ = 68 * MiB, WS_XNB = 84 * MiB, WS_H1 = 148 * MiB, WS_KVB = 276 * MiB, WS_QA = 340 * MiB, WS_Y = 388 * MiB;
constexpr size_t WS_HS = 388 * MiB;
constexpr size_t WS_YS_A = 148 * MiB;
constexpr size_t WS_G = 148 * MiB;
constexpr size_t WS_UH = 324 * MiB;
constexpr size_t WS_YS_B = 324 * MiB;
constexpr size_t WS_PB = 148 * MiB;
constexpr size_t WS_YS_C = 212 * MiB;
constexpr size_t WS_END = 512 * MiB;

__device__ __forceinline__ unsigned f2bf(float f) { unsigned u = __builtin_bit_cast(unsigned, f); return (u + 0x7fffu + ((u >> 16) & 1u)) >> 16; }
__device__ __forceinline__ float bf2f(bf16_t b) { return __builtin_bit_cast(float, ((unsigned)b) << 16); }
__device__ __forceinline__ float wave_sum(float v) {
#pragma unroll
    for (int o = 1; o < 64; o <<= 1) v += __shfl_xor(v, o);
    return v;
}
__device__ __forceinline__ float sigmoidf_(float x) { return 1.f / (1.f + __expf(-x)); }

__host__ __device__ __forceinline__ int rope_dim_of_slot(int p) { const int g = p >> 3, i = p & 7; return (i < 4) ? (4 * g + i) : (32 + 4 * g + (i - 4)); }

__global__ void k_prep_win(const float* __restrict__ w, bf16_t* __restrict__ dst) {
    const size_t idx = (size_t)blockIdx.x * blockDim.x + threadIdx.x; if (idx >= (size_t)NIN * DM) return;
    const int n = (int)(idx / DM), k = (int)(idx % DM);
    int oc = -1; float sc = 1.f;
    if (n < 2048) { oc = n; if (n >= 512 && n < 1024) sc = 0.08838834764831845f; }
    else if (n < 2304) oc = 2056 + (n - 2048);
    else if (n < 2432) oc = 2312 + (n - 2304);
    else if (n < 2496) oc = 2440 + rope_dim_of_slot(n - 2432);
    else if (n < 2500) oc = 2048 + (n - 2496);
    else if (n < 2504) oc = 2052 + (n - 2500);
    const float v = (oc >= 0) ? w[(size_t)k * IN_COLS + oc] * sc : 0.f;
    dst[idx] = (bf16_t)f2bf(v);
}
__global__ void k_prep_wuq(const float* __restrict__ w, const float* __restrict__ g, bf16_t* __restrict__ dst) {
    const int idx = blockIdx.x * blockDim.x + threadIdx.x; if (idx >= 768 * 256) return;
    const int n = idx / 256, k = idx % 256, h = n / 192, d = n % 192;
    const int oc = h * 192 + (d < 128 ? d : 128 + rope_dim_of_slot(d - 128));
    dst[idx] = (bf16_t)f2bf(w[(size_t)k * 768 + oc] * g[k]);
}
__global__ void k_prep_wukv(const float* __restrict__ w, const float* __restrict__ g, bf16_t* __restrict__ dst) {
    const int idx = blockIdx.x * blockDim.x + threadIdx.x; if (idx >= 1024 * 128) return;
    const int n = idx / 128, k = idx % 128;
    dst[idx] = (bf16_t)f2bf(w[(size_t)k * 1024 + n] * g[k]);
}
__global__ void k_prep_tr(const float* __restrict__ w, bf16_t* __restrict__ dst, int K, int N) {
    const size_t idx = (size_t)blockIdx.x * blockDim.x + threadIdx.x; if (idx >= (size_t)K * N) return;
    const int n = (int)(idx / K), k = (int)(idx % K);
    dst[idx] = (bf16_t)f2bf(w[(size_t)k * N + n]);
}
__global__ void k_prep_wup(const float* __restrict__ w, bf16_t* __restrict__ dst) {
    const size_t idx = (size_t)blockIdx.x * blockDim.x + threadIdx.x; if (idx >= (size_t)FF2 * DM) return;
    const int p = (int)(idx / DM), k = (int)(idx % DM);
    const int pn = p >> 8, r = p & 255, oc = ((r >> 7) ? FF : 0) + 128 * pn + (r & 127);
    dst[idx] = (bf16_t)f2bf(w[(size_t)k * FF2 + oc]);
}
__global__ void k_prep_x(const float* __restrict__ x, bf16_t* __restrict__ xb) {
    const size_t idx = (size_t)blockIdx.x * blockDim.x + threadIdx.x; if (idx >= (size_t)T * DM / 4) return;
    const f32x4 v = ((const f32x4*)x)[idx];
    uint2 o; o.x = f2bf(v[0]) | (f2bf(v[1]) << 16); o.y = f2bf(v[2]) | (f2bf(v[3]) << 16);
    ((uint2*)xb)[idx] = o;
}
__device__ __forceinline__ void sincos_reduced(double r, double& s, double& c) {
    const double r2 = r * r;
    double ss = 1.0, cc = 1.0;
#pragma unroll
    for (int n = 27; n >= 3; n -= 2) ss = 1.0 - ss * r2 / (double)((n) * (n - 1));
#pragma unroll
    for (int n = 26; n >= 2; n -= 2) cc = 1.0 - cc * r2 / (double)((n) * (n - 1));
    s = r * ss; c = cc;
}
__global__ void k_prep_rope(const int* __restrict__ pos, float* __restrict__ cs, float* __restrict__ sn) {
    const int idx = blockIdx.x * blockDim.x + threadIdx.x; if (idx >= T * 32) return;
    const int t = idx >> 5, r = idx & 31;
    const float inv_freq = (float)pow(10000.0, -(double)r / 32.0);
    const float ang = (float)pos[t] * inv_freq;
    const double a = (double)ang;
    const double n = rint(a * 0.15915494309189535);
    double rr = fma(-n, 6.283185307179586, a); rr = fma(-n, 2.4492935982947064e-16, rr);
    double s, c; sincos_reduced(rr, s, c);
    cs[idx] = (float)c; sn[idx] = (float)s;
}

template <class Epi>
__global__ __launch_bounds__(256) void k_sgemm(const bf16_t* __restrict__ A, const bf16_t* __restrict__ Bt, Epi epi, int lda, int ldb, int M, int N, int K, int pad_) {
    const int wid = threadIdx.x >> 6, lane = threadIdx.x & 63, fr = lane & 15, fq = lane >> 4;
    const int nbn = N / 128, bm = blockIdx.x / nbn, bn = blockIdx.x % nbn;
    const int r0 = bm * 128 + (wid >> 1) * 64, c0 = bn * 128 + (wid & 1) * 64;
    f32x4 acc[4][4];
#pragma unroll
    for (int i = 0; i < 4; ++i)
#pragma unroll
        for (int j = 0; j < 4; ++j) acc[i][j] = (f32x4){0.f, 0.f, 0.f, 0.f};
    const bf16_t* ap = A + (size_t)(r0 + fr) * lda + fq * 8;
    const bf16_t* bp = Bt + (size_t)(c0 + fr) * ldb + fq * 8;
    for (int k0 = 0; k0 < K; k0 += 32) {
        bf16x8 a[4], b[4];
#pragma unroll
        for (int i = 0; i < 4; ++i) { a[i] = *(const bf16x8*)(ap + (size_t)(16 * i) * lda + k0); b[i] = *(const bf16x8*)(bp + (size_t)(16 * i) * ldb + k0); }
#pragma unroll
        for (int mi = 0; mi < 4; ++mi)
#pragma unroll
            for (int ni = 0; ni < 4; ++ni) acc[mi][ni] = __builtin_amdgcn_mfma_f32_16x16x32_bf16(a[mi], b[ni], acc[mi][ni], 0, 0, 0);
    }
#pragma unroll
    for (int mi = 0; mi < 4; ++mi)
#pragma unroll
        for (int ni = 0; ni < 4; ++ni)
#pragma unroll
            for (int j = 0; j < 4; ++j) epi(r0 + 16 * mi + 4 * fq + j, c0 + 16 * ni + fr, acc[mi][ni][j]);
}
struct EpiWin { bf16_t* H1; float* Hs; __device__ void operator()(int r, int c, float v) const { if (c < 2048) H1[(size_t)r * 2048 + c] = (bf16_t)f2bf(v); else Hs[(size_t)r * 512 + (c - 2048)] = v; } };
struct EpiRs { bf16_t* O; const float* ssq; int ldo; int which; float inv_n; int pad; __device__ void operator()(int r, int c, float v) const {
    const float* s = ssq + (size_t)r * 8 + which * 4; const float rs = rsqrtf(((s[0] + s[1]) + (s[2] + s[3])) * inv_n + RMS_EPS); O[(size_t)r * ldo + c] = (bf16_t)f2bf(v * rs); } };
struct EpiF32 { float* O; const float* cscale; int ldo; int coff; __device__ void operator()(int r, int c, float v) const { O[(size_t)r * ldo + coff + c] = cscale ? v * cscale[coff + c] : v; } };
struct EpiB16 { bf16_t* O; int ldo; int pad; __device__ void operator()(int r, int c, float v) const { O[(size_t)r * ldo + c] = (bf16_t)f2bf(v); } };

__global__ __launch_bounds__(256) void k_rowpass(const float* __restrict__ Hs, const float* __restrict__ cs, const float* __restrict__ sn, const float* __restrict__ b_i, const float* __restrict__ b_f,
                                               bf16_t* __restrict__ CQ, bf16_t* __restrict__ CKV, bf16_t* __restrict__ KR, float* __restrict__ SSQ, float* __restrict__ GI, float* __restrict__ GF) {
    const int row = blockIdx.x * 4 + (threadIdx.x >> 6), lane = threadIdx.x & 63; if (row >= T) return;
    const float* h = Hs + (size_t)row * 512;
    const f32x4 q = *(const f32x4*)(h + lane * 4);
    float sq = (q[0] * q[0] + q[1] * q[1]) + (q[2] * q[2] + q[3] * q[3]); sq = wave_sum(sq);
    { uint2 o; o.x = f2bf(q[0]) | (f2bf(q[1]) << 16); o.y = f2bf(q[2]) | (f2bf(q[3]) << 16); *(uint2*)(CQ + (size_t)row * 256 + lane * 4) = o; }
    float sk = 0.f;
    if (lane < 32) { const f32x4 kv = *(const f32x4*)(h + 256 + lane * 4); sk = (kv[0] * kv[0] + kv[1] * kv[1]) + (kv[2] * kv[2] + kv[3] * kv[3]);
        uint2 o; o.x = f2bf(kv[0]) | (f2bf(kv[1]) << 16); o.y = f2bf(kv[2]) | (f2bf(kv[3]) << 16); *(uint2*)(CKV + (size_t)row * 128 + lane * 4) = o; }
    sk = wave_sum(sk);
    if (lane < 8) SSQ[(size_t)row * 8 + lane] = (lane == 0) ? sq : (lane == 4 ? sk : 0.f);
    if (lane < 32) { const int r = lane, g = r >> 2, i = r & 3; const float x1 = h[384 + 8 * g + i], x2 = h[384 + 8 * g + 4 + i], c = cs[(size_t)row * 32 + r], s = sn[(size_t)row * 32 + r];
        KR[(size_t)row * 64 + 8 * g + i] = (bf16_t)f2bf(x1 * c - x2 * s); KR[(size_t)row * 64 + 8 * g + 4 + i] = (bf16_t)f2bf(x2 * c + x1 * s); }
    if (lane < 4) { GI[(size_t)row * 4 + lane] = h[448 + lane] + b_i[lane]; GF[(size_t)row * 4 + lane] = h[452 + lane] + b_f[lane]; }
}
__global__ void k_rope_q(bf16_t* __restrict__ QA, const float* __restrict__ cs, const float* __restrict__ sn) {
    const int idx = blockIdx.x * blockDim.x + threadIdx.x; if (idx >= T * 4 * 32) return;
    const int row = idx >> 7, h = (idx >> 5) & 3, r = idx & 31, g = r >> 2, i = r & 3;
    bf16_t* p = QA + (size_t)row * 768 + h * 192 + 128 + 8 * g + i;
    const float x1 = bf2f(p[0]), x2 = bf2f(p[4]), c = cs[(size_t)row * 32 + r], s = sn[(size_t)row * 32 + r];
    p[0] = (bf16_t)f2bf(x1 * c - x2 * s); p[4] = (bf16_t)f2bf(x2 * c + x1 * s);
}

__global__ __launch_bounds__(256) void k_attn_naive(const bf16_t* __restrict__ QA, const bf16_t* __restrict__ KVB, const bf16_t* __restrict__ KR, bf16_t* __restrict__ Y) {
    __shared__ unsigned Kt[64][97];
    __shared__ unsigned Vt[64][65];
    const int qblk = blockIdx.x % (SEQ / 64), bh = blockIdx.x / (SEQ / 64), b = bh >> 2, h = bh & 3;
    const int tid = threadIdx.x, qi = tid >> 2, part = tid & 3;
    const int qpos = qblk * 64 + qi; const size_t qrow = (size_t)b * SEQ + qpos;
    float q[48];
#pragma unroll
    for (int i = 0; i < 48; ++i) q[i] = bf2f(QA[qrow * 768 + h * 192 + part * 48 + i]);
    float o[32];
#pragma unroll
    for (int i = 0; i < 32; ++i) o[i] = 0.f;
    float m = -1e30f, l = 0.f;
    const float scale = 0.07216878364870322f;
    for (int kt = 0; kt <= qblk; ++kt) {
        __syncthreads();
        for (int e = tid; e < 64 * 96; e += 256) { const int j = e / 96, c = e % 96; const size_t krow = (size_t)b * SEQ + kt * 64 + j;
            unsigned v; if (c < 64) v = *(const unsigned*)(KVB + krow * 1024 + h * 256 + 2 * c); else v = *(const unsigned*)(KR + krow * 64 + 2 * (c - 64)); Kt[j][c] = v; }
        for (int e = tid; e < 64 * 64; e += 256) { const int j = e / 64, c = e % 64; const size_t krow = (size_t)b * SEQ + kt * 64 + j; Vt[j][c] = *(const unsigned*)(KVB + krow * 1024 + h * 256 + 128 + 2 * c); }
        __syncthreads();
        for (int j = 0; j < 64; ++j) {
            float s = 0.f;
#pragma unroll
            for (int i = 0; i < 24; ++i) { const unsigned w = Kt[j][part * 24 + i]; s += q[2 * i] * __builtin_bit_cast(float, w << 16) + q[2 * i + 1] * __builtin_bit_cast(float, w & 0xffff0000u); }
            s += __shfl_xor(s, 1); s += __shfl_xor(s, 2);
            s *= scale;
            if (kt * 64 + j > qpos) s = -__builtin_inff();
            const float mn = fmaxf(m, s), al = __expf(m - mn), p = __expf(s - mn);
            l = l * al + p; m = mn;
#pragma unroll
            for (int i = 0; i < 16; ++i) { const unsigned w = Vt[j][part * 16 + i]; o[2 * i] = o[2 * i] * al + p * __builtin_bit_cast(float, w << 16); o[2 * i + 1] = o[2 * i + 1] * al + p * __builtin_bit_cast(float, w & 0xffff0000u); }
        }
    }
    const float il = 1.f / l;
#pragma unroll
    for (int i = 0; i < 32; ++i) Y[qrow * 1024 + 512 + h * 128 + part * 32 + i] = (bf16_t)f2bf(o[i] * il);
}

__global__ __launch_bounds__(256) void k_mlstm_naive(const bf16_t* __restrict__ H1, const float* __restrict__ GI, const float* __restrict__ GF, const float* __restrict__ nw, bf16_t* __restrict__ Y) {
    __shared__ float qs[128], ks[128], vs[128], red[8];
    const int b = blockIdx.x >> 2, h = blockIdx.x & 3, tid = threadIdx.x, v = tid >> 1, kh = tid & 1, wid = tid >> 6, lane = tid & 63;
    float C[64];
#pragma unroll
    for (int i = 0; i < 64; ++i) C[i] = 0.f;
    float n = 0.f;
    const float gw = nw[h * 128 + v];
    for (int s = 0; s < SEQ; ++s) {
        const size_t row = (size_t)b * SEQ + s;
        if (tid < 128) { qs[tid] = bf2f(H1[row * 2048 + h * 128 + tid]); ks[tid] = bf2f(H1[row * 2048 + 512 + h * 128 + tid]); vs[tid] = bf2f(H1[row * 2048 + 1024 + h * 128 + tid]); }
        const float ig = __expf(GI[row * 4 + h]), fg = sigmoidf_(GF[row * 4 + h]);
        __syncthreads();
        const float vv = vs[v] * ig; float acc = 0.f;
#pragma unroll
        for (int i = 0; i < 64; ++i) { C[i] = fg * C[i] + vv * ks[64 * kh + i]; acc += C[i] * qs[64 * kh + i]; }
        acc += __shfl_xor(acc, 1);
        float dp = 0.f;
        if (tid < 128) { n = fg * n + ig * ks[tid]; dp = n * qs[tid]; }
        dp = wave_sum(dp);
        if (lane == 0) red[wid] = dp;
        __syncthreads();
        const float den = red[0] + red[1];
        const float hv = acc / fmaxf(fabsf(den), 1.f);
        float sq = (kh == 0) ? hv * hv : 0.f; sq = wave_sum(sq);
        if (lane == 0) red[4 + wid] = sq;
        __syncthreads();
        const float rs = rsqrtf(((red[4] + red[5]) + (red[6] + red[7])) * (1.f / 128.f) + RMS_EPS);
        if (kh == 0) { const float og = sigmoidf_(bf2f(H1[row * 2048 + 1536 + h * 128 + v])); Y[row * 1024 + h * 128 + v] = (bf16_t)f2bf(hv * rs * gw * og); }
    }
}

__global__ __launch_bounds__(256) void k_ln(const float* xin, const float* __restrict__ ys, const float* __restrict__ g, const float* __restrict__ bta, float* out, bf16_t* __restrict__ outb) {
    const int row = blockIdx.x * 4 + (threadIdx.x >> 6), lane = threadIdx.x & 63; if (row >= T) return;
    f32x4 v[4]; float s = 0.f;
#pragma unroll
    for (int j = 0; j < 4; ++j) { const f32x4 a = *(const f32x4*)(xin + (size_t)row * DM + j * 256 + lane * 4), y = *(const f32x4*)(ys + (size_t)row * DM + j * 256 + lane * 4); v[j] = a * ALPHA + y; s += (v[j][0] + v[j][1]) + (v[j][2] + v[j][3]); }
    const float mean = wave_sum(s) * (1.f / DM); float s2 = 0.f;
#pragma unroll
    for (int j = 0; j < 4; ++j) { v[j] = v[j] - mean; s2 += (v[j][0] * v[j][0] + v[j][1] * v[j][1]) + (v[j][2] * v[j][2] + v[j][3] * v[j][3]); }
    const float rstd = rsqrtf(wave_sum(s2) * (1.f / DM) + LN_EPS);
#pragma unroll
    for (int j = 0; j < 4; ++j) { const int c = j * 256 + lane * 4; const f32x4 gg = *(const f32x4*)(g + c), bb = *(const f32x4*)(bta + c); const f32x4 o = v[j] * rstd * gg + bb;
        *(f32x4*)(out + (size_t)row * DM + c) = o; uint2 w; w.x = f2bf(o[0]) | (f2bf(o[1]) << 16); w.y = f2bf(o[2]) | (f2bf(o[3]) << 16); *(uint2*)(outb + (size_t)row * DM + c) = w; }
}

__global__ void k_convact(const bf16_t* __restrict__ U, const float* __restrict__ cw, const float* __restrict__ cb, bf16_t* __restrict__ G, int row0, int pad_) {
    const size_t idx = (size_t)blockIdx.x * blockDim.x + threadIdx.x; if (idx >= (size_t)(T / 2) * FF) return;
    const int rl = (int)(idx / FF), c = (int)(idx % FF), row = row0 + rl, s = row % SEQ;
    const int pg = 256 * (c >> 7) + (c & 127), pv = pg + 128;
    float gate = cb[c], val = cb[FF + c];
#pragma unroll
    for (int j = 0; j < 3; ++j) { const int d = 2 - j; if (s - d >= 0) { gate += cw[j * FF2 + c] * bf2f(U[(size_t)(rl - d) * FF2 + pg]); val += cw[j * FF2 + FF + c] * bf2f(U[(size_t)(rl - d) * FF2 + pv]); } }
    G[(size_t)row * FF + c] = (bf16_t)f2bf(gate * sigmoidf_(gate) * val);
}
__global__ void k_pool(const float* __restrict__ X, bf16_t* __restrict__ PB) {
    const size_t idx = (size_t)blockIdx.x * blockDim.x + threadIdx.x; if (idx >= (size_t)T * DM) return;
    const int row = (int)(idx / DM), ch = (int)(idx % DM), s = row % SEQ, w = 2 << (ch >> 8), cnt = (s + 1 < w) ? s + 1 : w;
    float sum = 0.f; for (int j = 0; j < cnt; ++j) sum += X[(size_t)(row - j) * DM + ch];
    PB[idx] = (bf16_t)f2bf(sum / (float)cnt - X[idx]);
}

namespace pg8 {
#define PG8_LAS __attribute__((address_space(3)))
typedef unsigned u32x4 __attribute__((ext_vector_type(4)));
typedef unsigned u32x2 __attribute__((ext_vector_type(2)));
constexpr int BM = 256, BK = 64, HALF = 128, HTB = HALF * BK * 2  , STAGE_BYTES = 8 * HTB, NXCD = 8, WGM = 8;
__host__ __device__ __forceinline__ int lds_byte(int r, int c) { const int st = (r >> 4) * 2 + (c >> 5), rr = r & 15, cc = c & 31, ob = rr * 64 + cc * 2; return st * 1024 + (ob ^ (((ob >> 9) & 1) << 5)); }
__host__ __device__ __forceinline__ void stage_rc(int b, int& R, int& C) { const int st = b / 1024, sb = b % 1024, swz = sb ^ (((sb >> 9) & 1) << 5); R = (st >> 1) * 16 + swz / 64; C = (st & 1) * 32 + (swz % 64) / 2; }
__host__ __device__ __forceinline__ int perm32(int rho) { const int n = rho >> 4, i = rho & 15; return 8 * (i >> 2) + 4 * n + (i & 3); }

struct Unit { int pm, pn; };
struct Gemm { const bf16_t* A; const bf16_t* Bt; int K, lda, ldb, a_pn_off; };
struct StaticOrder {
    int nM, nN, nwg, G, c;
    __host__ __device__ void init(int nM_, int nN_, int G_, int c_) { nM = nM_; nN = nN_; nwg = nM * nN; G = G_; c = c_; }
    __host__ __device__ bool next(int i, Unit& u) const {
        const long L = (long)i * G + c; if (L >= nwg) return false;
        int wgid = (int)L; { const int q = nwg / NXCD, r = nwg % NXCD, xcd = wgid % NXCD, off = wgid / NXCD; wgid = (xcd < r ? xcd * (q + 1) : r * (q + 1) + (xcd - r) * q) + off; }
        const int nig = WGM * nN, gid = wgid / nig, fm = gid * WGM, gsz = (nM - fm) < WGM ? (nM - fm) : WGM;
        u.pm = fm + ((wgid % nig) % gsz); u.pn = (wgid % nig) / gsz; return true;
    }
    __device__ __forceinline__ void a_ready(const Unit&) const {}
    __device__ __forceinline__ void done(const Unit&) const {}
};
struct AMapStd  { static constexpr int HROWS = 128; __device__ static __forceinline__ int slot_row(int R) { return R; } __device__ static __forceinline__ long tile_row0(int pm) { return 256L * pm; } };
struct AMapConv { static constexpr int HROWS = 64;  __device__ static __forceinline__ int slot_row(int R) { return (R >> 6) * 126 + (R & 63); } __device__ static __forceinline__ long tile_row0(int pm) { return 252L * pm - 2; } };

__device__ __forceinline__ unsigned cvt_pk_bf16(float lo, float hi) { unsigned r; asm volatile("v_cvt_pk_bf16_f32 %0, %1, %2" : "=v"(r) : "v"(lo), "v"(hi)); return r; }
__device__ __forceinline__ u32x4 pack8(const f32x4& a, const f32x4& b) { u32x4 w; w.x = cvt_pk_bf16(a[0], a[1]); w.y = cvt_pk_bf16(a[2], a[3]); w.z = cvt_pk_bf16(b[0], b[1]); w.w = cvt_pk_bf16(b[2], b[3]); return w; }

template <class Epi, class Sched, class AMap, bool ALIGN_EPI, bool SP2>
__device__ __forceinline__ void gemm_phase(PG8_LAS unsigned char* lds, const Gemm g, const Sched& S, const Epi& E) {
    int tid_ = threadIdx.x; asm volatile("" : "+v"(tid_));
    const int tid = tid_, wid = __builtin_amdgcn_readfirstlane(tid >> 6), lane = tid & 63, wr = wid >> 2, wc = wid & 3, fr = lane & 15, fq = lane >> 4;
    const int K = g.K, nt = K / BK;
    unsigned voffA[2], voffB[2];
#pragma unroll
    for (int i = 0; i < 2; ++i) { int R, C; stage_rc(tid * 16 + i * 8192, R, C); const int Rb = Epi::PERM ? ((R & ~31) + perm32(R & 31)) : R;
        voffA[i] = (unsigned)(AMap::slot_row(R) * g.lda + C) * 2u; voffB[i] = (unsigned)(Rb * g.ldb + C) * 2u; }
    const size_t kstep = (size_t)(BK * 2);
    const size_t hstepA = (size_t)AMap::HROWS * g.lda * 2, hstepB = (size_t)HALF * g.ldb * 2, tstepB = 2 * hstepB;
    const unsigned ldsw = (unsigned)wid * 1024u;
    const int aoff = lds_byte(wr * 64 + fr, fq * 8), boff = lds_byte(wc * 32 + fr, fq * 8);
#define PG8_SA(b, h) (((b) * 2 + (h)) * HTB)
#define PG8_SB(b, h) ((4 + (b) * 2 + (h)) * HTB)
#define PG8_STAGE(bufoff, gbase, voff) do { _Pragma("unroll") for (int _i = 0; _i < 2; ++_i) \
        __builtin_amdgcn_global_load_lds((const unsigned*)((const char*)(gbase) + (voff)[_i]), (PG8_LAS unsigned*)(lds + (bufoff) + ldsw + _i * 8192), 16, 0, 0); } while (0)
#define PG8_LDA(dst, b, h) do { _Pragma("unroll") for (int m = 0; m < 4; ++m) _Pragma("unroll") for (int k = 0; k < 2; ++k) dst[m][k] = *(const PG8_LAS bf16x8*)(lds + PG8_SA(b, h) + aoff + m * 2048 + k * 1024); } while (0)
#define PG8_LDB(dst, b, h) do { _Pragma("unroll") for (int n = 0; n < 2; ++n) _Pragma("unroll") for (int k = 0; k < 2; ++k) dst[n][k] = *(const PG8_LAS bf16x8*)(lds + PG8_SB(b, h) + boff + n * 2048 + k * 1024); } while (0)
#define PG8_MMA(ai, bj, At, Bt) do { __builtin_amdgcn_s_setprio(1); _Pragma("unroll") for (int m = 0; m < 4; ++m) _Pragma("unroll") for (int n = 0; n < 2; ++n) _Pragma("unroll") for (int k = 0; k < 2; ++k) \
        acc[ai][bj][m][n] = __builtin_amdgcn_mfma_f32_16x16x32_bf16(Bt[n][k], At[m][k], acc[ai][bj][m][n], 0, 0, 0); __builtin_amdgcn_s_setprio(0); } while (0)
#define PG8_WAIT_V(n) asm volatile("s_waitcnt vmcnt(" #n ")" ::: "memory")
#define PG8_WAIT_L(n) asm volatile("s_waitcnt lgkmcnt(" #n ")" ::: "memory")
#define PG8_BAR __builtin_amdgcn_s_barrier()
#define PG8_SCHED __builtin_amdgcn_sched_barrier(0)
#define PG8_ABASE(u_) ((const char*)g.A + (AMap::tile_row0((u_).pm) * (long)g.lda) * 2 + (long)(u_).pn * g.a_pn_off)
#define PG8_BBASE(u_) ((const char*)g.Bt + (size_t)(u_).pn * tstepB)
    Unit cur, nxt; int ui = 0;
    if (!S.next(0, cur)) return;
    f32x4 acc[2][2][4][2];
#pragma unroll
    for (int a = 0; a < 2; ++a)
#pragma unroll
        for (int b = 0; b < 2; ++b)
#pragma unroll
            for (int m = 0; m < 4; ++m)
#pragma unroll
                for (int n = 0; n < 2; ++n) acc[a][b][m][n] = (f32x4){0.f, 0.f, 0.f, 0.f};
    bf16x8 At[4][2], B0[2][2], B1[2][2];
    const char* cA = PG8_ABASE(cur); const char* cB = PG8_BBASE(cur);
    S.a_ready(cur);
    if constexpr (SP2) {
        PG8_STAGE(PG8_SB(0, 0), cB, voffB); PG8_STAGE(PG8_SB(0, 1), cB + hstepB, voffB); PG8_STAGE(PG8_SA(0, 0), cA, voffA); PG8_STAGE(PG8_SA(0, 1), cA + hstepA, voffA);
        if (wr == 1) PG8_BAR;
        PG8_WAIT_V(2); PG8_BAR;
        PG8_STAGE(PG8_SB(1, 0), cB + kstep, voffB); PG8_STAGE(PG8_SA(1, 0), cA + kstep, voffA); PG8_STAGE(PG8_SB(1, 1), cB + hstepB + kstep, voffB);
        PG8_WAIT_V(6); PG8_BAR;
    } else {
        PG8_STAGE(PG8_SB(0, 0), cB, voffB); PG8_STAGE(PG8_SA(0, 0), cA, voffA); PG8_STAGE(PG8_SB(0, 1), cB + hstepB, voffB); PG8_STAGE(PG8_SA(0, 1), cA + hstepA, voffA);
        if (wr == 1) PG8_BAR;
        PG8_WAIT_V(4); PG8_BAR;
        PG8_STAGE(PG8_SB(1, 0), cB + kstep, voffB); PG8_STAGE(PG8_SA(1, 0), cA + kstep, voffA); PG8_STAGE(PG8_SB(1, 1), cB + hstepB + kstep, voffB);
        PG8_WAIT_V(6); PG8_BAR;
    }
    for (;;) {
        const bool has_next = S.next(ui + 1, nxt);
        const char* nA = has_next ? PG8_ABASE(nxt) : cA; const char* nB = has_next ? PG8_BBASE(nxt) : cB;
        for (int t = 0; t < nt; t += 2) {
            const bool last = (t == nt - 2);
            const char* a1 = cA + (size_t)(t + 1) * kstep;
            const char* a2 = last ? nA : cA + (size_t)(t + 2) * kstep; const char* b2 = last ? nB : cB + (size_t)(t + 2) * kstep;
            const char* a3 = a2 + kstep; const char* b3 = b2 + kstep;
            if (last && has_next) S.a_ready(nxt);
            if constexpr (SP2) {
            PG8_LDB(B0, 0, 0); PG8_LDB(B1, 0, 1); PG8_SCHED; PG8_LDA(At, 0, 0); PG8_STAGE(PG8_SA(1, 1), a1 + hstepA, voffA);
            PG8_WAIT_V(8); PG8_WAIT_L(0); PG8_BAR; PG8_MMA(0, 0, At, B0); PG8_MMA(0, 1, At, B1); PG8_BAR; PG8_SCHED;
            PG8_LDA(At, 0, 1); PG8_STAGE(PG8_SB(0, 0), b2, voffB); PG8_STAGE(PG8_SB(0, 1), b2 + hstepB, voffB); PG8_STAGE(PG8_SA(0, 0), a2, voffA);
            PG8_WAIT_V(8); PG8_WAIT_L(0); PG8_BAR; PG8_MMA(1, 0, At, B0); PG8_MMA(1, 1, At, B1); PG8_BAR; PG8_SCHED;
            PG8_LDB(B0, 1, 0); PG8_LDB(B1, 1, 1); PG8_SCHED; PG8_LDA(At, 1, 0); PG8_STAGE(PG8_SA(0, 1), a2 + hstepA, voffA);
            PG8_WAIT_V(8); PG8_WAIT_L(0); PG8_BAR; PG8_MMA(0, 0, At, B0); PG8_MMA(0, 1, At, B1); PG8_BAR; PG8_SCHED;
            PG8_LDA(At, 1, 1); PG8_STAGE(PG8_SB(1, 0), b3, voffB); PG8_STAGE(PG8_SB(1, 1), b3 + hstepB, voffB); PG8_STAGE(PG8_SA(1, 0), a3, voffA);
            PG8_WAIT_V(8); PG8_WAIT_L(0); PG8_BAR; PG8_MMA(1, 0, At, B0); PG8_MMA(1, 1, At, B1); PG8_BAR; PG8_SCHED;
            } else {
            PG8_LDB(B0, 0, 0); PG8_SCHED; PG8_LDA(At, 0, 0); PG8_STAGE(PG8_SA(1, 1), a1 + hstepA, voffA);
            PG8_WAIT_L(8); PG8_BAR; PG8_WAIT_L(0); PG8_MMA(0, 0, At, B0); PG8_BAR; PG8_SCHED;
            PG8_LDB(B1, 0, 1); PG8_STAGE(PG8_SB(0, 0), b2, voffB);
            PG8_BAR; PG8_WAIT_L(0); PG8_MMA(0, 1, At, B1); PG8_BAR;
            PG8_LDA(At, 0, 1); PG8_STAGE(PG8_SA(0, 0), a2, voffA);
            PG8_BAR; PG8_WAIT_L(0); PG8_MMA(1, 0, At, B0); PG8_BAR; PG8_SCHED;
            PG8_STAGE(PG8_SB(0, 1), b2 + hstepB, voffB);
            PG8_WAIT_V(6); PG8_BAR; PG8_MMA(1, 1, At, B1); PG8_BAR;
            PG8_LDB(B0, 1, 0); PG8_SCHED; PG8_LDA(At, 1, 0); PG8_STAGE(PG8_SA(0, 1), a2 + hstepA, voffA);
            PG8_WAIT_L(8); PG8_BAR; PG8_WAIT_L(0); PG8_MMA(0, 0, At, B0); PG8_BAR; PG8_SCHED;
            PG8_LDB(B1, 1, 1); PG8_STAGE(PG8_SB(1, 0), b3, voffB);
            PG8_BAR; PG8_WAIT_L(0); PG8_MMA(0, 1, At, B1); PG8_BAR;
            PG8_LDA(At, 1, 1); PG8_STAGE(PG8_SA(1, 0), a3, voffA);
            PG8_BAR; PG8_WAIT_L(0); PG8_MMA(1, 0, At, B0); PG8_BAR; PG8_SCHED;
            PG8_STAGE(PG8_SB(1, 1), b3 + hstepB, voffB);
            PG8_WAIT_V(6); PG8_BAR; PG8_MMA(1, 1, At, B1); PG8_BAR;
            }
        }
        if constexpr (ALIGN_EPI) { if (wr == 0) PG8_BAR; }
        if constexpr (!Epi::AFTER_DRAIN) { E(acc, cur, wr, wc, fr, fq); S.done(cur); }
        if (!has_next) break;
#pragma unroll
        for (int a = 0; a < 2; ++a)
#pragma unroll
            for (int b = 0; b < 2; ++b)
#pragma unroll
                for (int m = 0; m < 4; ++m)
#pragma unroll
                    for (int n = 0; n < 2; ++n) acc[a][b][m][n] = (f32x4){0.f, 0.f, 0.f, 0.f};
        cur = nxt; cA = nA; cB = nB; ++ui;
        if constexpr (ALIGN_EPI) { if (wr == 1) PG8_BAR; }
    }
    PG8_WAIT_V(0);
    if constexpr (!ALIGN_EPI) { if (wr == 0) PG8_BAR; }
    PG8_BAR;
    if constexpr (Epi::AFTER_DRAIN) { E.fused(acc, cur, wr, wc, fr, fq, lds, wid, lane); S.done(cur); }
#undef PG8_SA
#undef PG8_SB
#undef PG8_STAGE
#undef PG8_LDA
#undef PG8_LDB
#undef PG8_MMA
#undef PG8_WAIT_V
#undef PG8_WAIT_L
#undef PG8_BAR
#undef PG8_SCHED
#undef PG8_ABASE
#undef PG8_BBASE
}

struct EpiWin { static constexpr bool PERM = true, AFTER_DRAIN = false;
    bf16_t* H1; bf16_t* CQ; bf16_t* CKV; bf16_t* KR; float* SSQ; float* GI; float* GF; const float* COS; const float* SIN; const float* b_i; const float* b_f;
    __device__ __forceinline__ void operator()(const f32x4 (&acc)[2][2][4][2], const Unit& u, int wr, int wc, int fr, int fq) const {
        const int row0 = u.pm * BM + wr * 64 + fr;
        if (u.pn < 8) {
#pragma unroll
            for (int ai = 0; ai < 2; ++ai)
#pragma unroll
                for (int m = 0; m < 4; ++m) { bf16_t* rowp = H1 + (size_t)(row0 + ai * HALF + m * 16) * 2048 + u.pn * BM + wc * 32 + 8 * fq;
#pragma unroll
                    for (int bj = 0; bj < 2; ++bj) *(u32x4*)(rowp + bj * HALF) = pack8(acc[ai][bj][m][0], acc[ai][bj][m][1]); }
        } else if (u.pn == 8) {
#pragma unroll
            for (int ai = 0; ai < 2; ++ai)
#pragma unroll
                for (int m = 0; m < 4; ++m) { const size_t row = (size_t)(row0 + ai * HALF + m * 16); float s = 0.f;
#pragma unroll
                    for (int bj = 0; bj < 2; ++bj)
#pragma unroll
                        for (int n = 0; n < 2; ++n) { const f32x4 x = acc[ai][bj][m][n]; s += (x[0] * x[0] + x[1] * x[1]) + (x[2] * x[2] + x[3] * x[3]); }
                    s += __shfl_xor(s, 16); s += __shfl_xor(s, 32);
                    if (fq == 0) SSQ[row * 8 + wc] = s;
#pragma unroll
                    for (int bj = 0; bj < 2; ++bj) *(u32x4*)(CQ + row * 256 + bj * HALF + wc * 32 + 8 * fq) = pack8(acc[ai][bj][m][0], acc[ai][bj][m][1]); }
        } else {
            f32x4 bi = *(const f32x4*)b_i, bf = *(const f32x4*)b_f;
#pragma unroll
            for (int ai = 0; ai < 2; ++ai)
#pragma unroll
                for (int m = 0; m < 4; ++m) { const size_t row = (size_t)(row0 + ai * HALF + m * 16);
                    const f32x4 x0 = acc[ai][0][m][0], x1 = acc[ai][0][m][1];
                    float s = ((x0[0] * x0[0] + x0[1] * x0[1]) + (x0[2] * x0[2] + x0[3] * x0[3])) + ((x1[0] * x1[0] + x1[1] * x1[1]) + (x1[2] * x1[2] + x1[3] * x1[3]));
                    s += __shfl_xor(s, 16); s += __shfl_xor(s, 32);
                    if (fq == 0) SSQ[row * 8 + 4 + wc] = s;
                    *(u32x4*)(CKV + row * 128 + wc * 32 + 8 * fq) = pack8(x0, x1);
                    const f32x4 a = acc[ai][1][m][0], b = acc[ai][1][m][1];
                    if (wc < 2) { const int g = 4 * wc + fq; const f32x4 c = *(const f32x4*)(COS + row * 32 + 4 * g), sn = *(const f32x4*)(SIN + row * 32 + 4 * g);
                        *(u32x4*)(KR + row * 64 + 8 * g) = pack8(a * c - b * sn, b * c + a * sn); }
                    else if (wc == 2 && fq == 0) { *(f32x4*)(GI + row * 4) = a + bi; *(f32x4*)(GF + row * 4) = b + bf; } }
        }
    }
};
struct EpiUq { static constexpr bool PERM = true, AFTER_DRAIN = false;
    bf16_t* QA; const float* SSQ; const float* COS; const float* SIN;
    __device__ __forceinline__ void operator()(const f32x4 (&acc)[2][2][4][2], const Unit& u, int wr, int wc, int fr, int fq) const {
        const int row0 = u.pm * BM + wr * 64 + fr;
#pragma unroll
        for (int ai = 0; ai < 2; ++ai)
#pragma unroll
            for (int m = 0; m < 4; ++m) { const size_t row = (size_t)(row0 + ai * HALF + m * 16); const f32x4 s4 = *(const f32x4*)(SSQ + row * 8);
                const float rs = rsqrtf(((s4[0] + s4[1]) + (s4[2] + s4[3])) * (1.f / 256.f) + RMS_EPS);
#pragma unroll
                for (int bj = 0; bj < 2; ++bj) { const int c = u.pn * BM + bj * HALF + wc * 32 + 8 * fq, d = c % 192;
                    f32x4 v0 = acc[ai][bj][m][0] * rs, v1 = acc[ai][bj][m][1] * rs;
                    if (d >= 128) { const int g = (d - 128) >> 3; const f32x4 cc = *(const f32x4*)(COS + row * 32 + 4 * g), sn = *(const f32x4*)(SIN + row * 32 + 4 * g);
                        const f32x4 o0 = v0 * cc - v1 * sn, o1 = v1 * cc + v0 * sn; v0 = o0; v1 = o1; }
                    *(u32x4*)(QA + row * 768 + c) = pack8(v0, v1); }
                asm volatile("" ::: "memory"); }
    }
};
struct EpiUkv { static constexpr bool PERM = true, AFTER_DRAIN = false;
    bf16_t* KVB; const float* SSQ;
    __device__ __forceinline__ void operator()(const f32x4 (&acc)[2][2][4][2], const Unit& u, int wr, int wc, int fr, int fq) const {
        const int row0 = u.pm * BM + wr * 64 + fr;
#pragma unroll
        for (int ai = 0; ai < 2; ++ai)
#pragma unroll
            for (int m = 0; m < 4; ++m) { const size_t row = (size_t)(row0 + ai * HALF + m * 16); const f32x4 s4 = *(const f32x4*)(SSQ + row * 8 + 4);
                const float rs = rsqrtf(((s4[0] + s4[1]) + (s4[2] + s4[3])) * (1.f / 128.f) + RMS_EPS);
#pragma unroll
                for (int bj = 0; bj < 2; ++bj) *(u32x4*)(KVB + row * 1024 + u.pn * BM + bj * HALF + wc * 32 + 8 * fq) = pack8(acc[ai][bj][m][0] * rs, acc[ai][bj][m][1] * rs);
                asm volatile("" ::: "memory"); }
    }
};

struct EpiF32 { static constexpr bool PERM = false, AFTER_DRAIN = false;
    float* C; const float* cscale; int ldc; int pad;
    __device__ __forceinline__ void operator()(const f32x4 (&acc)[2][2][4][2], const Unit& u, int wr, int wc, int fr, int fq) const {
        const int row0 = u.pm * BM + wr * 64 + fr, col0 = u.pn * BM + wc * 32 + 4 * fq;
        f32x4 sc[2][2];
#pragma unroll
        for (int bj = 0; bj < 2; ++bj)
#pragma unroll
            for (int n = 0; n < 2; ++n) sc[bj][n] = cscale ? *(const f32x4*)(cscale + col0 + bj * HALF + n * 16) : (f32x4){1.f, 1.f, 1.f, 1.f};
#pragma unroll
        for (int ai = 0; ai < 2; ++ai)
#pragma unroll
            for (int m = 0; m < 4; ++m) { float* rowp = C + (size_t)(row0 + ai * HALF + m * 16) * ldc + col0;
#pragma unroll
                for (int bj = 0; bj < 2; ++bj)
#pragma unroll
                    for (int n = 0; n < 2; ++n) *(f32x4*)(rowp + bj * HALF + n * 16) = acc[ai][bj][m][n] * sc[bj][n]; }
    }
};
template <int N> __device__ __forceinline__ float dpp_rows_back(float cur, float prevblk) {
    const int old = __builtin_amdgcn_update_dpp(0, __builtin_bit_cast(int, prevblk), 0x100 + (16 - N), 0xf, 0xf, true);
    return __builtin_bit_cast(float, __builtin_amdgcn_update_dpp(old, __builtin_bit_cast(int, cur), 0x110 + N, 0xf, 0xf, false));
}
template <int N> __device__ __forceinline__ f32x4 dpp_rows_back4(const f32x4& cur, const f32x4& prevblk) {
    f32x4 r; r[0] = dpp_rows_back<N>(cur[0], prevblk[0]); r[1] = dpp_rows_back<N>(cur[1], prevblk[1]); r[2] = dpp_rows_back<N>(cur[2], prevblk[2]); r[3] = dpp_rows_back<N>(cur[3], prevblk[3]); return r; }
struct EpiConv { static constexpr bool PERM = true, AFTER_DRAIN = false;
    bf16_t* G; const float* cw; const float* cb;
    __device__ __forceinline__ void operator()(const f32x4 (&acc)[2][2][4][2], const Unit& u, int wr, int wc, int fr, int fq) const {
        const long rowb = 252L * u.pm - 2 + 126 * wr;
        const int cg = 128 * u.pn + 32 * wc + 8 * fq;
        const bool has_start = ((rowb + 127) >> 12) != ((rowb - 1) >> 12);
#pragma unroll
        for (int n = 0; n < 2; ++n) {
            const int c = cg + 4 * n;
            const f32x4 wg0 = *(const f32x4*)(cw + c), wg1 = *(const f32x4*)(cw + FF2 + c), wg2 = *(const f32x4*)(cw + 2 * FF2 + c), bg = *(const f32x4*)(cb + c);
            const f32x4 wv0 = *(const f32x4*)(cw + FF + c), wv1 = *(const f32x4*)(cw + FF2 + FF + c), wv2 = *(const f32x4*)(cw + 2 * FF2 + FF + c), bv = *(const f32x4*)(cb + FF + c);
            f32x4 pg = acc[0][0][0][n], pv = acc[0][1][0][n];
#pragma unroll
            for (int ai = 0; ai < 2; ++ai)
#pragma unroll
                for (int m = 0; m < 4; ++m) {
                    const f32x4 ug = acc[ai][0][m][n], uv = acc[ai][1][m][n];
                    f32x4 g1 = dpp_rows_back4<1>(ug, pg), g2 = dpp_rows_back4<2>(ug, pg), v1 = dpp_rows_back4<1>(uv, pv), v2 = dpp_rows_back4<2>(uv, pv);
                    pg = ug; pv = uv;
                    const int j = 64 * ai + 16 * m + fr; const long row = rowb + j;
                    if (has_start) { const int sq = (int)(row & 4095); const f32x4 z = {0.f, 0.f, 0.f, 0.f};
                        if (sq == 0) { g1 = z; v1 = z; } if (sq <= 1) { g2 = z; v2 = z; } }
                    const f32x4 gate = bg + wg0 * g2 + wg1 * g1 + wg2 * ug, val = bv + wv0 * v2 + wv1 * v1 + wv2 * uv;
                    f32x4 o;
#pragma unroll
                    for (int i = 0; i < 4; ++i) o[i] = gate[i] * __builtin_amdgcn_rcpf(1.f + __expf(-gate[i])) * val[i];
                    if (j >= 2 && row < T) { u32x2 w; w.x = cvt_pk_bf16(o[0], o[1]); w.y = cvt_pk_bf16(o[2], o[3]); *(u32x2*)(G + (size_t)row * FF + c) = w; }
                }
        }
    }
};
}

#define LAS __attribute__((address_space(3)))
typedef unsigned v4u __attribute__((ext_vector_type(4)));
constexpr int MK_THREADS = 512, MK_LDS = 131072 + 4096;
struct Args { const void* in[21]; float* out; unsigned char* ws; int ph_lo, ph_hi; };
__device__ __forceinline__ unsigned pk2(float lo, float hi) { return f2bf(lo) | (f2bf(hi) << 16); }

struct MapId  { __device__ int src(int n) const { return n; } __device__ float scale(int) const { return 1.f; } };
struct MapWin { __device__ int src(int n) const { if (n < 2048) return n; if (n < 2304) return 2056 + (n - 2048); if (n < 2432) return 2312 + (n - 2304); if (n < 2496) return 2440 + rope_dim_of_slot(n - 2432);
                    if (n < 2500) return 2048 + (n - 2496); if (n < 2504) return 2052 + (n - 2500); return -1; }
                __device__ float scale(int n) const { return (n >= 512 && n < 1024) ? 0.08838834764831845f : 1.f; } };
struct MapUq  { __device__ int src(int n) const { const int h = n / 192, d = n % 192; return h * 192 + (d < 128 ? d : 128 + rope_dim_of_slot(d - 128)); } __device__ float scale(int) const { return 1.f; } };
struct MapWup { __device__ int src(int p) const { const int pn = p >> 8, r = p & 255; return ((r >> 7) ? FF : 0) + 128 * pn + (r & 127); } __device__ float scale(int) const { return 1.f; } };
template <class Map>
__device__ __forceinline__ void tr_item(const float* __restrict__ W, int Nsrc, int K, bf16_t* __restrict__ WT, const float* __restrict__ kscale, LAS float* scr, int item, int nblk, int lane, const Map map) {
    const int kb = item / nblk, nb = item % nblk, k0 = 64 * kb, n0 = 32 * nb;
    const int oc = map.src(n0 + (lane & 31)); const float cs = map.scale(n0 + (lane & 31));
#pragma unroll 8
    for (int i = 0; i < 32; ++i) { const int kk = 2 * i + (lane >> 5); float v = (oc >= 0) ? W[(size_t)(k0 + kk) * Nsrc + oc] * cs : 0.f; if (kscale) v *= kscale[k0 + kk]; scr[kk * 33 + (lane & 31)] = v; }
    asm volatile("s_waitcnt lgkmcnt(0)" ::: "memory");
    const int c = lane & 7;
#pragma unroll
    for (int j = 0; j < 4; ++j) { const int n = (lane >> 3) + 8 * j; const LAS float* s = scr + (8 * c) * 33 + n;
        v4u o; o.x = pk2(s[0 * 33], s[1 * 33]); o.y = pk2(s[2 * 33], s[3 * 33]); o.z = pk2(s[4 * 33], s[5 * 33]); o.w = pk2(s[6 * 33], s[7 * 33]);
        *(v4u*)(WT + (size_t)(n0 + n) * K + k0 + 8 * c) = o; }
    asm volatile("s_waitcnt lgkmcnt(0)" ::: "memory");
}
struct WsPtrs { bf16_t *Win_t, *Wuq_t, *Wukv_t, *Wout_t, *Wpool_t, *Wup_t, *Wdn_t, *KR, *CKV, *CQ, *XNB, *H1, *KVB, *QA, *Y; float *COS, *SIN, *GI, *GF, *SSQ; };
__host__ __device__ __forceinline__ WsPtrs ws_ptrs(unsigned char* ws) { WsPtrs p;
    p.Win_t = (bf16_t*)(ws + WS_WIN); p.Wuq_t = (bf16_t*)(ws + WS_WUQ); p.Wukv_t = (bf16_t*)(ws + WS_WUKV); p.Wout_t = (bf16_t*)(ws + WS_WOUT); p.Wpool_t = (bf16_t*)(ws + WS_WPOOL); p.Wup_t = (bf16_t*)(ws + WS_WUP); p.Wdn_t = (bf16_t*)(ws + WS_WDN);
    p.KR = (bf16_t*)(ws + WS_KR); p.CKV = (bf16_t*)(ws + WS_CKV); p.CQ = (bf16_t*)(ws + WS_CQ); p.XNB = (bf16_t*)(ws + WS_XNB); p.H1 = (bf16_t*)(ws + WS_H1); p.KVB = (bf16_t*)(ws + WS_KVB); p.QA = (bf16_t*)(ws + WS_QA); p.Y = (bf16_t*)(ws + WS_Y);
    p.COS = (float*)(ws + WS_COS); p.SIN = (float*)(ws + WS_SIN); p.GI = (float*)(ws + WS_GI); p.GF = (float*)(ws + WS_GF); p.SSQ = (float*)(ws + WS_SSQ); return p; }

__device__ __forceinline__ void p0_prologue(const Args& a, const WsPtrs& P, LAS unsigned char* lds) {
    int tid_ = threadIdx.x; asm volatile("" : "+v"(tid_));
    const int tid = tid_, lane = tid & 63, wave = __builtin_amdgcn_readfirstlane(tid >> 6);
    LAS float* scr = (LAS float*)(lds + wave * 16384);
    const int gw = blockIdx.x * 8 + wave, NGW = gridDim.x * 8;
    const float *w_in = (const float*)a.in[2], *qnorm = (const float*)a.in[6], *kvnorm = (const float*)a.in[7], *w_uq = (const float*)a.in[8], *w_ukv = (const float*)a.in[9], *w_out = (const float*)a.in[10], *pool_w = (const float*)a.in[11];
    const float *w_up = (const float*)a.in[13], *w_dn = (const float*)a.in[16];
    constexpr int I_IN = 16 * 80, I_UQ = 4 * 24, I_UKV = 2 * 32, I_OUT = 16 * 32, I_POOL = 4 * 8, I_UP = 16 * 176, I_DN = 44 * 32;
    constexpr int NITEMS = I_IN + I_UQ + I_UKV + I_OUT + 4 * I_POOL + 2 * I_UP + 2 * I_DN;
    for (int it = gw; it < NITEMS; it += NGW) {
        int r = it;
        if (r < I_IN) { tr_item(w_in, IN_COLS, DM, P.Win_t, nullptr, scr, r, 80, lane, MapWin{}); continue; } r -= I_IN;
        if (r < I_UQ) { tr_item(w_uq, 768, 256, P.Wuq_t, qnorm, scr, r, 24, lane, MapUq{}); continue; } r -= I_UQ;
        if (r < I_UKV) { tr_item(w_ukv, 1024, 128, P.Wukv_t, kvnorm, scr, r, 32, lane, MapId{}); continue; } r -= I_UKV;
        if (r < I_OUT) { tr_item(w_out, DM, DM, P.Wout_t, nullptr, scr, r, 32, lane, MapId{}); continue; } r -= I_OUT;
        if (r < 4 * I_POOL) { const int g = r / I_POOL; tr_item(pool_w + (size_t)g * 65536, 256, 256, P.Wpool_t + (size_t)g * 65536, nullptr, scr, r % I_POOL, 8, lane, MapId{}); continue; } r -= 4 * I_POOL;
        if (r < 2 * I_UP) { const int l = r / I_UP; tr_item(w_up + (size_t)l * DM * FF2, FF2, DM, P.Wup_t + (size_t)l * FF2 * DM, nullptr, scr, r % I_UP, 176, lane, MapWup{}); continue; } r -= 2 * I_UP;
        { const int l = r / I_DN; tr_item(w_dn + (size_t)l * FF * DM, DM, FF, P.Wdn_t + (size_t)l * DM * FF, nullptr, scr, r % I_DN, 32, lane, MapId{}); }
    }
    const size_t gt = (size_t)blockIdx.x * MK_THREADS + tid, NGT = (size_t)gridDim.x * MK_THREADS;
    const float* x = (const float*)a.in[0];
    for (size_t i = gt; i < (size_t)T * DM / 4; i += NGT) { const f32x4 v = ((const f32x4*)x)[i]; uint2 o; o.x = pk2(v[0], v[1]); o.y = pk2(v[2], v[3]); ((uint2*)P.XNB)[i] = o; }
    const int* pos = (const int*)a.in[1];
    for (size_t i = gt; i < (size_t)T * 32; i += NGT) { const int t = (int)(i >> 5), r = (int)(i & 31);
        const float inv_freq = (float)pow(10000.0, -(double)r / 32.0); const float ang = (float)pos[t] * inv_freq; const double ad = (double)ang;
        const double n = rint(ad * 0.15915494309189535); double rr = fma(-n, 6.283185307179586, ad); rr = fma(-n, 2.4492935982947064e-16, rr);
        double s, c; sincos_reduced(rr, s, c); P.COS[i] = (float)c; P.SIN[i] = (float)s; }
}


__device__ __forceinline__ void ln_phase(const float* xin, const float* __restrict__ ys, const float* __restrict__ g, const float* __restrict__ bta, float* out, bf16_t* __restrict__ outb) {
    int tid_ = threadIdx.x; asm volatile("" : "+v"(tid_));
    const int lane = tid_ & 63, gw = blockIdx.x * 8 + (tid_ >> 6), NGW = gridDim.x * 8;
    f32x4 gg[4], bb[4];
#pragma unroll
    for (int j = 0; j < 4; ++j) { gg[j] = *(const f32x4*)(g + j * 256 + lane * 4); bb[j] = *(const f32x4*)(bta + j * 256 + lane * 4); }
    for (int row = gw; row < T; row += NGW) {
        f32x4 v[4]; float s = 0.f;
#pragma unroll
        for (int j = 0; j < 4; ++j) { const f32x4 x4 = *(const f32x4*)(xin + (size_t)row * DM + j * 256 + lane * 4), y4 = *(const f32x4*)(ys + (size_t)row * DM + j * 256 + lane * 4); v[j] = x4 * ALPHA + y4; s += (v[j][0] + v[j][1]) + (v[j][2] + v[j][3]); }
        const float mean = wave_sum(s) * (1.f / DM); float s2 = 0.f;
#pragma unroll
        for (int j = 0; j < 4; ++j) { v[j] = v[j] - mean; s2 += (v[j][0] * v[j][0] + v[j][1] * v[j][1]) + (v[j][2] * v[j][2] + v[j][3] * v[j][3]); }
        const float rstd = rsqrtf(wave_sum(s2) * (1.f / DM) + LN_EPS);
#pragma unroll
        for (int j = 0; j < 4; ++j) { const int c = j * 256 + lane * 4; const f32x4 o = v[j] * rstd * gg[j] + bb[j];
            *(f32x4*)(out + (size_t)row * DM + c) = o; uint2 w; w.x = pk2(o[0], o[1]); w.y = pk2(o[2], o[3]); *(uint2*)(outb + (size_t)row * DM + c) = w; }
    }
}
__device__ __forceinline__ void pool_phase(const float* __restrict__ X, bf16_t* __restrict__ PB) {
    int tid_ = threadIdx.x; asm volatile("" : "+v"(tid_));
    const size_t gt = (size_t)blockIdx.x * MK_THREADS + tid_, NGT = (size_t)gridDim.x * MK_THREADS;
    for (size_t i = gt; i < (size_t)T * DM / 4; i += NGT) {
        const int row = (int)(i >> 8), c4 = (int)(i & 255), s = row & (SEQ - 1), w = 2 << (c4 >> 6), cnt = (s + 1 < w) ? s + 1 : w;
        const f32x4 x0 = *(const f32x4*)(X + (size_t)row * DM + c4 * 4); f32x4 sum = x0;
        for (int j = 1; j < cnt; ++j) sum = sum + *(const f32x4*)(X + (size_t)(row - j) * DM + c4 * 4);
        const f32x4 o = sum * (1.f / (float)cnt) - x0;
        uint2 wv; wv.x = pk2(o[0], o[1]); wv.y = pk2(o[2], o[3]); *(uint2*)(PB + (size_t)row * DM + c4 * 4) = wv;
    }
}

template <bool COOP>
__global__ void __launch_bounds__(MK_THREADS, 2) mk_fwd(Args a) {
    extern __shared__ __attribute__((aligned(16))) unsigned char lds_raw[];
    LAS unsigned char* lds = (LAS unsigned char*)lds_raw;
    const WsPtrs P = ws_ptrs(a.ws);
    const int lo = a.ph_lo, hi = a.ph_hi, G = gridDim.x;
#define IN(k) (lo <= (k) && (k) < hi)
    if (IN(0)) { p0_prologue(a, P, lds); __syncthreads(); }
    if (IN(1)) {
        pg8::Gemm g{P.XNB, P.Win_t, DM, DM, DM, 0}; pg8::StaticOrder S; S.init(T / 256, NIN / 256, G, (int)blockIdx.x);
        pg8::EpiWin E{P.H1, P.CQ, P.CKV, P.KR, P.SSQ, P.GI, P.GF, P.COS, P.SIN, (const float*)a.in[3], (const float*)a.in[4]};
        pg8::gemm_phase<pg8::EpiWin, pg8::StaticOrder, pg8::AMapStd, true, true>(lds, g, S, E);
    }
    if (IN(2)) {
        { pg8::Gemm g{P.CQ, P.Wuq_t, 256, 256, 256, 0}; pg8::StaticOrder S; S.init(T / 256, 3, G, (int)blockIdx.x);
          pg8::EpiUq E{P.QA, P.SSQ, P.COS, P.SIN};
          pg8::gemm_phase<pg8::EpiUq, pg8::StaticOrder, pg8::AMapStd, true, true>(lds, g, S, E); }
        { pg8::Gemm g{P.CKV, P.Wukv_t, 128, 128, 128, 0}; pg8::StaticOrder S; S.init(T / 256, 4, G, (int)blockIdx.x);
          pg8::EpiUkv E{P.KVB, P.SSQ};
          pg8::gemm_phase<pg8::EpiUkv, pg8::StaticOrder, pg8::AMapStd, true, true>(lds, g, S, E); }
    }
    if (IN(3)) {
        pg8::Gemm g{P.Y, P.Wout_t, DM, DM, DM, 0}; pg8::StaticOrder S; S.init(T / 256, 4, G, (int)blockIdx.x);
        pg8::EpiF32 E{(float*)(a.ws + WS_YS_A), nullptr, DM, 0};
        pg8::gemm_phase<pg8::EpiF32, pg8::StaticOrder, pg8::AMapStd, true, true>(lds, g, S, E);
    }
    if (IN(4)) ln_phase((const float*)a.in[0], (const float*)(a.ws + WS_YS_A), (const float*)a.in[17], (const float*)a.in[18], a.out, P.XNB);
#pragma unroll 1
    for (int l = 0; l < 2; ++l) {
        const int pb = 5 + 6 * l;
        if (l == 1) {
            if (IN(8)) pool_phase(a.out, (bf16_t*)(a.ws + WS_PB));
            if (IN(9)) { pg8::Gemm g{(const bf16_t*)(a.ws + WS_PB), P.Wpool_t, 256, DM, 256, 512}; pg8::StaticOrder S; S.init(T / 256, 4, G, (int)blockIdx.x);
                pg8::EpiF32 E{(float*)(a.ws + WS_YS_C), (const float*)a.in[12], DM, 0};
                pg8::gemm_phase<pg8::EpiF32, pg8::StaticOrder, pg8::AMapStd, true, true>(lds, g, S, E); }
            if (IN(10)) ln_phase(a.out, (const float*)(a.ws + WS_YS_C), (const float*)a.in[17] + DM, (const float*)a.in[18] + DM, a.out, P.XNB);
        }
        if (IN(pb)) {
            pg8::Gemm g{P.XNB, P.Wup_t + (size_t)l * FF2 * DM, DM, DM, DM, 0}; pg8::StaticOrder S; S.init(131, 22, G, (int)blockIdx.x);
            pg8::EpiConv E{(bf16_t*)(a.ws + WS_G), (const float*)a.in[14] + (size_t)l * 3 * FF2, (const float*)a.in[15] + (size_t)l * FF2};
            pg8::gemm_phase<pg8::EpiConv, pg8::StaticOrder, pg8::AMapConv, true, true>(lds, g, S, E);
        }
        if (IN(pb + 1)) {
            pg8::Gemm g{(const bf16_t*)(a.ws + WS_G), P.Wdn_t + (size_t)l * DM * FF, FF, FF, FF, 0}; pg8::StaticOrder S; S.init(T / 256, 4, G, (int)blockIdx.x);
            pg8::EpiF32 E{(float*)(a.ws + WS_YS_B), nullptr, DM, 0};
            pg8::gemm_phase<pg8::EpiF32, pg8::StaticOrder, pg8::AMapStd, true, true>(lds, g, S, E);
        }
        if (IN(pb + 2)) ln_phase(a.out, (const float*)(a.ws + WS_YS_B), (const float*)a.in[19] + (size_t)l * DM, (const float*)a.in[20] + (size_t)l * DM, a.out, P.XNB);
    }
#undef IN
}
namespace att {
constexpr int DK = 192, DV = 128, NW = 8, QBLK = 32, KVBLK = 64, QB = NW * QBLK;
constexpr int LQ = 768, LKN = 1024, LKR = 64, LV = 1024, LO = 1024;
constexpr int SHM_V = KVBLK * DV * 2, SHM_K = KVBLK * DK * 2;
constexpr int LDS_BYTES = 2 * SHM_V + 2 * SHM_K + NW * 64 * 4;
constexpr float SCALE = 0.07216878364870322f;
constexpr float THR = 8.f;
typedef short s16x4 __attribute__((ext_vector_type(4)));
typedef float f32x16 __attribute__((ext_vector_type(16)));
typedef unsigned u32x4 __attribute__((ext_vector_type(4)));
#define KSWZ(row, colB) ((row) * 384 + ((colB) ^ (((row) & 7) << 4)))
#define SBAR() __builtin_amdgcn_sched_barrier(0)
__device__ __forceinline__ int v_st(int k, int c) { const int kk = (k & ~0xC) | ((k & 4) << 1) | ((k & 8) >> 1); return ((kk >> 3) * 4 + (c >> 5)) * 512 + ((kk & 7) * 32 + (c & 31)) * 2; }
__device__ __forceinline__ int v_rd_base(int lane) { return ((lane & 3) << 3) | (((lane >> 2) & 3) << 6) | (((lane >> 4) & 1) << 5) | (((lane >> 5) & 1) << 8); }
constexpr int v_rd_off(int d0, int ks, int half) { return d0 * 512 + ks * 4096 + half * 2048; }
__device__ __forceinline__ int crow(int r, int hi) { return (r & 3) + 8 * (r >> 2) + 4 * hi; }
__device__ __forceinline__ unsigned cvtpk(float lo, float hi) { unsigned r; asm volatile("v_cvt_pk_bf16_f32 %0, %1, %2" : "=v"(r) : "v"(lo), "v"(hi)); return r; }
__device__ __forceinline__ bf16x8 load8(const bf16_t* p) { return *reinterpret_cast<const bf16x8*>(p); }
__device__ __forceinline__ void mask_tile(f32x16& p0, f32x16& p1, int dq) {
    const float NEG = -__builtin_inff();
#pragma unroll
    for (int r = 0; r < 16; ++r) { const int c = (r & 3) + 8 * (r >> 2); if (dq - c < 0) p0[r] = NEG; if (dq - c - 32 < 0) p1[r] = NEG; }
}
__device__ __forceinline__ void partialSM(f32x16& p0, f32x16& p1, float& m_reg, float& mn, float& alpha) {
    float pmax = p0[0];
#pragma unroll
    for (int r = 1; r < 16; ++r) pmax = fmaxf(pmax, p0[r]);
#pragma unroll
    for (int r = 0; r < 16; ++r) pmax = fmaxf(pmax, p1[r]);
    { auto rr = __builtin_amdgcn_permlane32_swap(__float_as_uint(pmax), __float_as_uint(pmax), false, false); pmax = fmaxf(__uint_as_float(rr[0]), __uint_as_float(rr[1])); }
    constexpr float C2 = 1.4426950408889634f * SCALE;
    if (__builtin_expect(__all((pmax - m_reg) * SCALE <= THR), 1)) { mn = m_reg; alpha = 1.f; }
    else { mn = fmaxf(m_reg, pmax); alpha = __builtin_amdgcn_exp2f((m_reg - mn) * C2); m_reg = mn; }
    const float mnL = -mn * C2;
#pragma unroll
    for (int r = 0; r < 16; ++r) p0[r] = fmaf(p0[r], C2, mnL);
#pragma unroll
    for (int r = 0; r < 16; ++r) p1[r] = fmaf(p1[r], C2, mnL);
#pragma unroll
    for (int r = 0; r < 16; ++r) p0[r] = __builtin_amdgcn_exp2f(p0[r]);
}
__device__ __forceinline__ void finishSM(f32x16& p0, f32x16& p1, float alpha, float& l_reg, bf16x8& pa0, bf16x8& pa1, bf16x8& pa2, bf16x8& pa3) {
#pragma unroll
    for (int r = 0; r < 16; ++r) p1[r] = __builtin_amdgcn_exp2f(p1[r]);
    float ps = 0;
#pragma unroll
    for (int r = 0; r < 16; ++r) ps += p0[r];
#pragma unroll
    for (int r = 0; r < 16; ++r) ps += p1[r];
    { auto rr = __builtin_amdgcn_permlane32_swap(__float_as_uint(ps), __float_as_uint(ps), false, false); ps = __uint_as_float(rr[0]) + __uint_as_float(rr[1]); }
    l_reg = l_reg * alpha + ps;
#define PK4(P, B_, OUT) do { unsigned a0 = cvtpk(P[B_+0], P[B_+1]), a1 = cvtpk(P[B_+2], P[B_+3]);                          \
        unsigned b0 = cvtpk(P[B_+4], P[B_+5]), b1 = cvtpk(P[B_+6], P[B_+7]);                                             \
        auto r0 = __builtin_amdgcn_permlane32_swap(a0, b0, false, false); auto r1 = __builtin_amdgcn_permlane32_swap(a1, b1, false, false); \
        u32x4 w = {r0[0], r1[0], r0[1], r1[1]}; OUT = *reinterpret_cast<bf16x8*>(&w); } while (0)
    PK4(p0, 0, pa0); PK4(p0, 8, pa1); PK4(p1, 0, pa2); PK4(p1, 8, pa3);
#undef PK4
}
template <int KB>
__device__ __forceinline__ void qkt(f32x16& p0, f32x16& p1, const char* K_lds, int r32, int hi, const bf16x8* qr) {
    p0 = f32x16{}; p1 = f32x16{};
    const char* kb[4];
#pragma unroll
    for (int dd = 0; dd < 4; ++dd) kb[dd] = K_lds + KB * SHM_K + KSWZ(r32, (dd * 16 + hi * 8) * 2);
#pragma unroll
    for (int d0 = 0; d0 < 12; ++d0) { const char* a = kb[d0 & 3] + (d0 >> 2) * 128;
        bf16x8 b0 = *reinterpret_cast<const bf16x8*>(a);
        bf16x8 b1 = *reinterpret_cast<const bf16x8*>(a + 32 * 384);
        p0 = __builtin_amdgcn_mfma_f32_32x32x16_bf16(b0, qr[d0], p0, 0, 0, 0);
        p1 = __builtin_amdgcn_mfma_f32_32x32x16_bf16(b1, qr[d0], p1, 0, 0, 0); }
}
template <int VB>
__device__ __forceinline__ void pv_tile(f32x16* o, int vb0, bf16x8 pa0, bf16x8 pa1, bf16x8 pa2, bf16x8 pa3) {
#define TRRD(dst, off) asm volatile("ds_read_b64_tr_b16 %0, %1 offset:%2" : "=&v"(dst) : "v"(vb0), "i"(off) : "memory")
#define PV_D0(d0) do { s16x4 l0, l1, l2, l3, h0, h1, h2, h3; constexpr int b_ = VB * SHM_V + v_rd_off(d0, 0, 0); \
        TRRD(l0, b_); TRRD(h0, b_ + 2048); TRRD(l1, b_ + 4096); TRRD(h1, b_ + 6144); TRRD(l2, b_ + 8192); TRRD(h2, b_ + 10240); TRRD(l3, b_ + 12288); TRRD(h3, b_ + 14336); \
        asm volatile("s_waitcnt lgkmcnt(0)" ::: "memory"); SBAR();   \
        o[d0] = __builtin_amdgcn_mfma_f32_32x32x16_bf16(pa0, (bf16x8){l0[0], l0[1], l0[2], l0[3], h0[0], h0[1], h0[2], h0[3]}, o[d0], 0, 0, 0);   \
        o[d0] = __builtin_amdgcn_mfma_f32_32x32x16_bf16(pa1, (bf16x8){l1[0], l1[1], l1[2], l1[3], h1[0], h1[1], h1[2], h1[3]}, o[d0], 0, 0, 0);   \
        o[d0] = __builtin_amdgcn_mfma_f32_32x32x16_bf16(pa2, (bf16x8){l2[0], l2[1], l2[2], l2[3], h2[0], h2[1], h2[2], h2[3]}, o[d0], 0, 0, 0);   \
        o[d0] = __builtin_amdgcn_mfma_f32_32x32x16_bf16(pa3, (bf16x8){l3[0], l3[1], l3[2], l3[3], h3[0], h3[1], h3[2], h3[3]}, o[d0], 0, 0, 0); } while (0)
    PV_D0(0); PV_D0(1); PV_D0(2); PV_D0(3);
#undef PV_D0
#undef TRRD
}
struct BlockRef { const bf16_t* Q; const bf16_t* Kn; const bf16_t* Kr; const bf16_t* V; bf16_t* O; int P0; };
#define VMW() asm volatile("s_waitcnt vmcnt(0)" ::: "memory")
#define SLOAD_H(R_, k0) do { st_v0 = load8((R_).V + (size_t)((k0) + sr) * LV + sc); st_v1 = load8((R_).V + (size_t)((k0) + 32 + sr) * LV + sc);              \
                             st_k0 = load8((R_).Kn + (size_t)((k0) + sr) * LKN + sc); st_k1 = load8((R_).Kn + (size_t)((k0) + 32 + sr) * LKN + sc); \
                             st_k2 = load8((R_).Kr + (size_t)((k0) + rr_) * LKR + 8 * cr_); } while (0)
#define SWRITE_H(bf) do { *(bf16x8*)(V_lds + (bf) * SHM_V + vst0) = st_v0; *(bf16x8*)(V_lds + (bf) * SHM_V + vst1) = st_v1; \
                          *(bf16x8*)(K_lds + (bf) * SHM_K + kws) = st_k0; *(bf16x8*)(K_lds + (bf) * SHM_K + kws + 32 * 384) = st_k1; *(bf16x8*)(K_lds + (bf) * SHM_K + kwr) = st_k2; } while (0)
__device__ __forceinline__ void attn_block(const BlockRef& cur, char* lds) {
    int tid_ = threadIdx.x; asm volatile("" : "+v"(tid_));
    const int tid = tid_, wid = __builtin_amdgcn_readfirstlane(tid >> 6), lane = tid & 63, r32 = lane & 31, hi = lane >> 5;
    const int NT = (cur.P0 + QB - 1) / KVBLK + 1;
    const int qlo = cur.P0 + wid * QBLK, qm = qlo + r32 - 4 * hi;
    char* V_lds = lds; char* K_lds = lds + 2 * SHM_V;
    float* ws = (float*)(lds + 2 * SHM_V + 2 * SHM_K) + wid * 64; float* li_l = ws, * al_l = ws + 32;
    float m_reg = -1e30f, l_reg = 0; f32x16 o[4] = {};
    const int sr = tid >> 4, sc = (tid & 15) * 8, rr_ = tid >> 3, cr_ = tid & 7, vst0 = v_st(sr, sc), vst1 = v_st(32 + sr, sc), kws = KSWZ(sr, sc * 2), kwr = KSWZ(rr_, 256 + 16 * cr_);
    const int vb0 = (int)(uintptr_t)V_lds + v_rd_base(lane);
    bf16x8 qr[12]; bf16x8 st_v0, st_v1, st_k0, st_k1, st_k2;
#pragma unroll
    for (int d0 = 0; d0 < 12; ++d0) qr[d0] = load8(cur.Q + (size_t)(wid * QBLK + r32) * LQ + d0 * 16 + hi * 8);
    SLOAD_H(cur, 0); VMW(); SWRITE_H(0);
    __syncthreads();
#define STEP(t, BUF) do { f32x16 p0, p1; float mn, alpha; bf16x8 pa0, pa1, pa2, pa3;                                         \
        if ((t) + 1 < NT) { SLOAD_H(cur, ((t) + 1) * KVBLK); SBAR(); }                                                           \
        qkt<BUF>(p0, p1, K_lds, r32, hi, qr);                                                                                  \
        { const int kb_ = (t) * KVBLK; if (kb_ + KVBLK - 1 > qlo) mask_tile(p0, p1, qm - kb_); }                                \
        partialSM(p0, p1, m_reg, mn, alpha); finishSM(p0, p1, alpha, l_reg, pa0, pa1, pa2, pa3);                                \
        if (__any(alpha < 1.f)) { if (hi == 0) al_l[r32] = alpha; asm volatile("s_waitcnt lgkmcnt(0)" ::: "memory");            \
            for (int d_ = 0; d_ < 4; ++d_) for (int r = 0; r < 16; ++r) o[d_][r] *= al_l[crow(r, hi)]; }                          \
        SBAR(); pv_tile<BUF>(o, vb0, pa0, pa1, pa2, pa3);                                                                       \
        if ((t) + 1 < NT) { VMW(); SWRITE_H((BUF) ^ 1); }                                                                        \
        __syncthreads(); } while (0)
    for (int t = 0; t < NT; t += 2) { STEP(t, 0); STEP(t + 1, 1); }
#undef STEP
    if (hi == 0) li_l[r32] = l_reg; asm volatile("s_waitcnt lgkmcnt(0)" ::: "memory");
    float rli[16];
#pragma unroll
    for (int r = 0; r < 16; ++r) rli[r] = __builtin_amdgcn_rcpf(li_l[crow(r, hi)]);
    bf16_t* Ow = cur.O + (size_t)(wid * QBLK) * LO;
#pragma unroll
    for (int r = 0; r < 16; ++r) { const int orow = crow(r, hi);
#pragma unroll
        for (int d0 = 0; d0 < 4; ++d0) { const float v = o[d0][r] * rli[r]; const float vn = __shfl_xor(v, 1);
            if ((r32 & 1) == 0) *(unsigned*)(Ow + (size_t)orow * LO + d0 * 32 + r32) = cvtpk(v, vn); } }
    __syncthreads();
}
#undef VMW
#undef SLOAD_H
#undef SWRITE_H
#undef KSWZ
#undef SBAR
__device__ __forceinline__ BlockRef block_ref(int bh, int qb, const bf16_t* QA, const bf16_t* KVB, const bf16_t* KR, bf16_t* Y) {
    const int b = bh >> 2, h = bh & 3; const size_t row0 = (size_t)b * SEQ; BlockRef r;
    r.Q = QA + (row0 + (size_t)qb * QB) * LQ + h * DK; r.Kn = KVB + row0 * LKN + h * 256; r.Kr = KR + row0 * LKR; r.V = KVB + row0 * LV + h * 256 + 128;
    r.O = Y + (row0 + (size_t)qb * QB) * LO + 512 + h * DV; r.P0 = qb * QB; return r;
}
__device__ __forceinline__ void attn_phase(char* lds, const bf16_t* QA, const bf16_t* KVB, const bf16_t* KR, bf16_t* Y, int first_item, int item_stride, int n_items) {
    for (int L = first_item; L < n_items; L += item_stride) {
        attn_block(block_ref(L >> 3, L & 7, QA, KVB, KR, Y), lds);
        attn_block(block_ref(L >> 3, 15 - (L & 7), QA, KVB, KR, Y), lds);
    }
}
}
__global__ void __launch_bounds__(512, 2) k_attn_fast(const bf16_t* QA, const bf16_t* KVB, const bf16_t* KR, bf16_t* Y) {
    extern __shared__ __attribute__((aligned(16))) char lds_attn[];
    att::attn_phase(lds_attn, QA, KVB, KR, Y, (int)blockIdx.x, (int)gridDim.x, 256);
}
namespace mls {
constexpr int TILE = 16384, TAB0 = 131072;
constexpr int T_A = 0, T_M = 256, T_SC = 512, T_EM = 768, T_W = 1024, T_N = 1280, T_DEC = 1792, TABSZ = 2048;
constexpr int DN0 = TAB0 + 2 * TABSZ, SSQ0 = DN0 + 512, LDS_NEED = SSQ0 + 2048;
typedef short v4i16_t __attribute__((ext_vector_type(4)));
typedef float f32x16 __attribute__((ext_vector_type(16)));
typedef unsigned u32x2 __attribute__((ext_vector_type(2)));
typedef unsigned u32x4 __attribute__((ext_vector_type(4)));
__device__ __forceinline__ int OFF(int row, int ch) { return 256 * row + 16 * (ch ^ (((row & 3) << 2) | ((row >> 2) & 3))); }
__device__ __forceinline__ unsigned cvtpk(float lo, float hi) { unsigned r; asm volatile("v_cvt_pk_bf16_f32 %0, %1, %2" : "=v"(r) : "v"(lo), "v"(hi)); return r; }
__device__ __forceinline__ bf16x8 pack8r(const f32x16& x, int b0) { u32x4 w; w.x = cvtpk(x[b0], x[b0 + 1]); w.y = cvtpk(x[b0 + 2], x[b0 + 3]); w.z = cvtpk(x[b0 + 4], x[b0 + 5]); w.w = cvtpk(x[b0 + 6], x[b0 + 7]); return __builtin_bit_cast(bf16x8, w); }
__device__ __forceinline__ v4i16_t trr(LAS unsigned char* p) { return __builtin_amdgcn_ds_read_tr16_b64_v4i16((LAS v4i16_t*)p); }
__device__ __forceinline__ bf16x8 join8(v4i16_t a, v4i16_t b) { return (bf16x8){a[0], a[1], a[2], a[3], b[0], b[1], b[2], b[3]}; }

__device__ __forceinline__ void mlstm_unit(int b, int h, LAS unsigned char* lds, const bf16_t* __restrict__ H1, const float* __restrict__ GI, const float* __restrict__ GF, const float* __restrict__ normw, bf16_t* __restrict__ Y) {
    int tid_ = threadIdx.x; asm volatile("" : "+v"(tid_));
    const int tid = tid_, wid = __builtin_amdgcn_readfirstlane(tid >> 6), lane = tid & 63, r32 = lane & 31, hi = lane >> 5;
    const size_t row0 = (size_t)b * SEQ;
    constexpr int NC = SEQ / 64;
    const int lt = tid - 256;
    float m_carry = 0.f; float n_reg0 = 0.f, n_reg1 = 0.f;
#define MLS_TAB(p) (lds + TAB0 + (p) * TABSZ)
#define MLS_LOAD_TILES(cn) do { const int pn_ = (cn) & 1; u32x4 tv[16];                                                               \
        _Pragma("unroll") for (int x = 0; x < 4; ++x) _Pragma("unroll") for (int i = 0; i < 4; ++i) { const int idx = lt + 256 * i, row = idx >> 4, ch = idx & 15; \
            tv[x * 4 + i] = *(const u32x4*)(H1 + (row0 + (size_t)(cn) * 64 + row) * 2048 + x * 512 + h * 128 + 8 * ch); }                                        \
        _Pragma("unroll") for (int x = 0; x < 4; ++x) _Pragma("unroll") for (int i = 0; i < 4; ++i) { const int idx = lt + 256 * i, row = idx >> 4, ch = idx & 15; \
            *(LAS u32x4*)(lds + pn_ * 65536 + x * TILE + OFF(row, ch)) = tv[x * 4 + i]; } } while (0)
#define MLS_GATES(cn) do { const int pn_ = (cn) & 1; const size_t rw = row0 + (size_t)(cn) * 64 + lane;                                   \
        const float gi = GI[rw * 4 + h], gf = GF[rw * 4 + h];                                                                            \
        const float lf = fminf(gf, 0.f) - log1pf(__expf(-fabsf(gf)));                                                                     \
        float bb = lf;                                                                                                                    \
        _Pragma("unroll") for (int o = 1; o < 64; o <<= 1) { const float v_ = __shfl_up(bb, o); if (lane >= o) bb += v_; }               \
        const float aa = gi - bb; float mx = aa;                                                                                          \
        _Pragma("unroll") for (int o = 1; o < 64; o <<= 1) { const float v_ = __shfl_up(mx, o); if (lane >= o) mx = fmaxf(mx, v_); }      \
        const float Mv = fmaxf(mx, m_carry); const float M63 = __shfl(Mv, 63), b63 = __shfl(bb, 63);                                      \
        LAS float* tb_ = (LAS float*)MLS_TAB(pn_);                                                                                       \
        tb_[T_A / 4 + lane] = aa; tb_[T_M / 4 + lane] = Mv; tb_[T_SC / 4 + lane] = __expf(m_carry - Mv); tb_[T_EM / 4 + lane] = __expf(-(bb + Mv)); \
        tb_[T_W / 4 + lane] = __expf(aa - M63); if (lane == 0) tb_[T_DEC / 4] = __expf(m_carry - M63);                                    \
        m_carry = b63 + M63; } while (0)

    f32x16 X[4]; f32x16 hg[2]; float dint[2] = {0.f, 0.f}, sc_r[2] = {0.f, 0.f}, em_r[2] = {1.f, 1.f};
#pragma unroll
    for (int kb = 0; kb < 4; ++kb) X[kb] = f32x16{};
    hg[0] = f32x16{}; hg[1] = f32x16{};
    const int w = wid;
    const int g16 = (lane >> 4) & 1, q4 = (lane & 15) >> 2, p4 = lane & 3;
    if (wid >= 4) {
        MLS_LOAD_TILES(0);
        if (wid == 4) MLS_GATES(0);
        if (wid == 5) { LAS float* tb_ = (LAS float*)MLS_TAB(0); tb_[T_N / 4 + lane] = 0.f; tb_[T_N / 4 + 64 + lane] = 0.f; }
    }
    __syncthreads();
#pragma unroll 1
    for (int c = 0; c < NC; ++c) {
        const int p = c & 1;
        LAS unsigned char* Qt = lds + p * 65536; LAS unsigned char* Kt = Qt + TILE; LAS unsigned char* Vt = Qt + 2 * TILE; LAS unsigned char* Ot = Qt + 3 * TILE;
        LAS float* tab = (LAS float*)MLS_TAB(p);
        if (wid < 4) {
            if (c > 0) { const int pp = p ^ 1;
#pragma unroll
                for (int tb = 0; tb < 2; ++tb) { const int t = 32 * tb + r32;
                    const float den = dint[tb] + sc_r[tb] * ((LAS float*)(lds + DN0))[pp * 64 + t]; const float inv = 1.f / fmaxf(fabsf(den), em_r[tb]);
                    LAS float* sq = (LAS float*)(lds + SSQ0) + pp * 256 + t; const float ssq = ((sq[0] + sq[64]) + (sq[128] + sq[192])) * inv * inv;
                    const float scale = inv * rsqrtf(ssq * (1.f / 128.f) + RMS_EPS);
                    bf16_t* dst = Y + (row0 + (size_t)(c - 1) * 64 + t) * 1024 + h * 128 + 32 * w + 4 * hi;
#pragma unroll
                    for (int q = 0; q < 4; ++q) { u32x2 o2; o2.x = cvtpk(hg[tb][4 * q] * scale, hg[tb][4 * q + 1] * scale); o2.y = cvtpk(hg[tb][4 * q + 2] * scale, hg[tb][4 * q + 3] * scale); *(u32x2*)(dst + 8 * q) = o2; } } }
            sc_r[0] = tab[T_SC / 4 + r32]; sc_r[1] = tab[T_SC / 4 + 32 + r32]; em_r[0] = tab[T_EM / 4 + r32]; em_r[1] = tab[T_EM / 4 + 32 + r32];
            f32x16 acc[2]; acc[0] = f32x16{}; acc[1] = f32x16{};
#pragma unroll
            for (int kb = 0; kb < 4; ++kb)
#pragma unroll
                for (int s2 = 0; s2 < 2; ++s2) { const bf16x8 a = pack8r(X[kb], 8 * s2);
#pragma unroll
                    for (int tb = 0; tb < 2; ++tb) { const int t = 32 * tb + r32;
                        const v4i16_t lo = *(const LAS v4i16_t*)(Qt + OFF(t, 4 * kb + 2 * s2) + 8 * hi), hi8 = *(const LAS v4i16_t*)(Qt + OFF(t, 4 * kb + 2 * s2 + 1) + 8 * hi);
                        acc[tb] = __builtin_amdgcn_mfma_f32_32x32x16_bf16(a, join8(lo, hi8), acc[tb], 0, 0, 0); } }
#pragma unroll
            for (int tb = 0; tb < 2; ++tb)
#pragma unroll
                for (int r = 0; r < 16; ++r) acc[tb][r] *= sc_r[tb];
            float dsum[2] = {0.f, 0.f};
#pragma unroll
            for (int tl = 0; tl < 3; ++tl) { const int sb = tl >> 1, tb = (tl + 1) >> 1;
                f32x16 st = f32x16{};
#pragma unroll
                for (int ks = 0; ks < 8; ++ks) { const bf16x8 a = *(const LAS bf16x8*)(Kt + OFF(32 * sb + r32, 2 * ks + hi)), bq = *(const LAS bf16x8*)(Qt + OFF(32 * tb + r32, 2 * ks + hi));
                    st = __builtin_amdgcn_mfma_f32_32x32x16_bf16(a, bq, st, 0, 0, 0); }
                const float Mt = tab[T_M / 4 + 32 * tb + r32];
#pragma unroll
                for (int q = 0; q < 4; ++q) { const f32x4 a4 = *(const LAS f32x4*)(tab + T_A / 4 + 32 * sb + 8 * q + 4 * hi);
#pragma unroll
                    for (int i = 0; i < 4; ++i) { float e = __expf(a4[i] - Mt); if (sb == tb && (8 * q + 4 * hi + i) > r32) e = 0.f; const float v = st[4 * q + i] * e; st[4 * q + i] = v; dsum[tb] += v; } }
#pragma unroll
                for (int ks = 0; ks < 2; ++ks) { const int s0 = 32 * sb + 16 * ks + 4 * hi;
                    const v4i16_t lo = trr(Vt + OFF(s0 + q4, 4 * w + 2 * g16 + (p4 >> 1)) + 8 * (p4 & 1)), hi8 = trr(Vt + OFF(s0 + 8 + q4, 4 * w + 2 * g16 + (p4 >> 1)) + 8 * (p4 & 1));
                    acc[tb] = __builtin_amdgcn_mfma_f32_32x32x16_bf16(join8(lo, hi8), pack8r(st, 8 * ks), acc[tb], 0, 0, 0); } }
#pragma unroll
            for (int tb = 0; tb < 2; ++tb) { dsum[tb] += __shfl_xor(dsum[tb], 32); dint[tb] = dsum[tb]; }
#pragma unroll
            for (int tb = 0; tb < 2; ++tb) { const int t = 32 * tb + r32; float ss = 0.f;
#pragma unroll
                for (int r = 0; r < 16; ++r) ss += acc[tb][r] * acc[tb][r];
                ss += __shfl_xor(ss, 32);
                if (hi == 0) ((LAS float*)(lds + SSQ0))[p * 256 + w * 64 + t] = ss;
#pragma unroll
                for (int q = 0; q < 4; ++q) { const u32x2 ov = *(const LAS u32x2*)(Ot + OFF(t, 4 * w + q) + 8 * hi);
                    const float o0 = __builtin_bit_cast(float, ov.x << 16), o1 = __builtin_bit_cast(float, ov.x & 0xffff0000u), o2 = __builtin_bit_cast(float, ov.y << 16), o3 = __builtin_bit_cast(float, ov.y & 0xffff0000u);
                    const f32x4 nw4 = *(const f32x4*)(normw + h * 128 + 32 * w + 8 * q + 4 * hi);
                    hg[tb][4 * q] = acc[tb][4 * q] * sigmoidf_(o0) * nw4[0]; hg[tb][4 * q + 1] = acc[tb][4 * q + 1] * sigmoidf_(o1) * nw4[1];
                    hg[tb][4 * q + 2] = acc[tb][4 * q + 2] * sigmoidf_(o2) * nw4[2]; hg[tb][4 * q + 3] = acc[tb][4 * q + 3] * sigmoidf_(o3) * nw4[3]; } }
            const float dec = tab[T_DEC / 4];
#pragma unroll
            for (int kb = 0; kb < 4; ++kb)
#pragma unroll
                for (int r = 0; r < 16; ++r) X[kb][r] *= dec;
#pragma unroll
            for (int ks = 0; ks < 4; ++ks) { const int s0 = 16 * ks + 8 * hi;
                const v4i16_t vlo = trr(Vt + OFF(s0 + q4, 4 * w + 2 * g16 + (p4 >> 1)) + 8 * (p4 & 1)), vhi = trr(Vt + OFF(s0 + 4 + q4, 4 * w + 2 * g16 + (p4 >> 1)) + 8 * (p4 & 1));
                const f32x4 w0 = *(const LAS f32x4*)(tab + T_W / 4 + s0), w1 = *(const LAS f32x4*)(tab + T_W / 4 + s0 + 4);
                u32x4 bwv;
                bwv.x = cvtpk(bf2f((bf16_t)vlo[0]) * w0[0], bf2f((bf16_t)vlo[1]) * w0[1]); bwv.y = cvtpk(bf2f((bf16_t)vlo[2]) * w0[2], bf2f((bf16_t)vlo[3]) * w0[3]);
                bwv.z = cvtpk(bf2f((bf16_t)vhi[0]) * w1[0], bf2f((bf16_t)vhi[1]) * w1[1]); bwv.w = cvtpk(bf2f((bf16_t)vhi[2]) * w1[2], bf2f((bf16_t)vhi[3]) * w1[3]);
                const bf16x8 bw = __builtin_bit_cast(bf16x8, bwv);
#pragma unroll
                for (int kb = 0; kb < 4; ++kb) {
                    const v4i16_t klo = trr(Kt + OFF(s0 + q4, 4 * kb + 2 * g16 + (p4 >> 1)) + 8 * (p4 & 1)), khi = trr(Kt + OFF(s0 + 4 + q4, 4 * kb + 2 * g16 + (p4 >> 1)) + 8 * (p4 & 1));
                    X[kb] = __builtin_amdgcn_mfma_f32_32x32x16_bf16(join8(klo, khi), bw, X[kb], 0, 0, 0); } }
        } else {
            if (c + 1 < NC) MLS_LOAD_TILES(c + 1);
            if (wid == 4) { if (c + 1 < NC) MLS_GATES(c + 1); }
            else if (wid == 5) {
                const float dec = tab[T_DEC / 4]; float a0 = 0.f, a1 = 0.f;
                for (int s = 0; s < 64; ++s) { const float ws_ = tab[T_W / 4 + s];
                    a0 += ws_ * bf2f(*(const LAS bf16_t*)(Kt + OFF(s, lane >> 3) + 2 * (lane & 7))); a1 += ws_ * bf2f(*(const LAS bf16_t*)(Kt + OFF(s, 8 + (lane >> 3)) + 2 * (lane & 7))); }
                n_reg0 = dec * n_reg0 + a0; n_reg1 = dec * n_reg1 + a1;
                LAS float* tn = (LAS float*)MLS_TAB(p ^ 1); tn[T_N / 4 + lane] = n_reg0; tn[T_N / 4 + 64 + lane] = n_reg1;
            } else if (wid == 6) {
                float d = 0.f;
#pragma unroll
                for (int ch = 0; ch < 16; ++ch) { const u32x4 qv = *(const LAS u32x4*)(Qt + OFF(lane, ch)); const f32x4 n0 = *(const LAS f32x4*)(tab + T_N / 4 + 8 * ch), n1 = *(const LAS f32x4*)(tab + T_N / 4 + 8 * ch + 4);
                    d += __builtin_bit_cast(float, qv.x << 16) * n0[0] + __builtin_bit_cast(float, qv.x & 0xffff0000u) * n0[1] + __builtin_bit_cast(float, qv.y << 16) * n0[2] + __builtin_bit_cast(float, qv.y & 0xffff0000u) * n0[3]
                       + __builtin_bit_cast(float, qv.z << 16) * n1[0] + __builtin_bit_cast(float, qv.z & 0xffff0000u) * n1[1] + __builtin_bit_cast(float, qv.w << 16) * n1[2] + __builtin_bit_cast(float, qv.w & 0xffff0000u) * n1[3]; }
                ((LAS float*)(lds + DN0))[p * 64 + lane] = d;
            }
        }
        __syncthreads();
    }
    if (wid < 4) {
        const int pp = (NC - 1) & 1;
#pragma unroll
        for (int tb = 0; tb < 2; ++tb) { const int t = 32 * tb + r32;
            const float den = dint[tb] + sc_r[tb] * ((LAS float*)(lds + DN0))[pp * 64 + t]; const float inv = 1.f / fmaxf(fabsf(den), em_r[tb]);
            LAS float* sq = (LAS float*)(lds + SSQ0) + pp * 256 + t; const float ssq = ((sq[0] + sq[64]) + (sq[128] + sq[192])) * inv * inv;
            const float scale = inv * rsqrtf(ssq * (1.f / 128.f) + RMS_EPS);
            bf16_t* dst = Y + (row0 + (size_t)(NC - 1) * 64 + t) * 1024 + h * 128 + 32 * w + 4 * hi;
#pragma unroll
            for (int q = 0; q < 4; ++q) { u32x2 o2; o2.x = cvtpk(hg[tb][4 * q] * scale, hg[tb][4 * q + 1] * scale); o2.y = cvtpk(hg[tb][4 * q + 2] * scale, hg[tb][4 * q + 3] * scale); *(u32x2*)(dst + 8 * q) = o2; } }
    }
    __syncthreads();
#undef MLS_TAB
#undef MLS_LOAD_TILES
#undef MLS_GATES
}
}
__global__ void __launch_bounds__(512, 2) k_mlstm_fast(const bf16_t* H1, const float* GI, const float* GF, const float* normw, bf16_t* Y) {
    extern __shared__ __attribute__((aligned(16))) unsigned char lds_ml[];
    mls::mlstm_unit((int)blockIdx.x >> 2, (int)blockIdx.x & 3, (LAS unsigned char*)lds_ml, H1, GI, GF, normw, Y);
}
template <class Epi> static void sgemm(const bf16_t* A, int lda, const bf16_t* Bt, int ldb, int M, int N, int K, Epi e, hipStream_t st) {
    k_sgemm<Epi><<<dim3((M / 128) * (N / 128)), dim3(256), 0, st>>>(A, Bt, e, lda, ldb, M, N, K, 0);
}
extern "C" void kernel_launch(void* const* d_in, const int* in_sizes, int n_in, void* d_out, int out_size, void* d_ws, size_t ws_size, hipStream_t stream) {
    if (n_in != 21 || in_sizes[0] != T * DM || out_size != T * DM || ws_size < WS_END) { fprintf(stderr, "kernel_launch: unexpected shapes (n_in %d, in0 %d, out %d, ws %zu)\n", n_in, n_in > 0 ? in_sizes[0] : -1, out_size, ws_size); return; }
    static bool attr_done = false;
    if (!attr_done) { attr_done = true;
        hipError_t e = hipFuncSetAttribute((const void*)mk_fwd<false>, hipFuncAttributeMaxDynamicSharedMemorySize, MK_LDS);
        if (e != hipSuccess) fprintf(stderr, "kernel_launch: hipFuncSetAttribute: %s\n", hipGetErrorString(e));
        e = hipFuncSetAttribute((const void*)k_mlstm_fast, hipFuncAttributeMaxDynamicSharedMemorySize, mls::LDS_NEED);
        if (e != hipSuccess) fprintf(stderr, "kernel_launch: hipFuncSetAttribute(mlstm): %s\n", hipGetErrorString(e));
        e = hipFuncSetAttribute((const void*)k_attn_fast, hipFuncAttributeMaxDynamicSharedMemorySize, att::LDS_BYTES);
        if (e != hipSuccess) fprintf(stderr, "kernel_launch: hipFuncSetAttribute(attn): %s\n", hipGetErrorString(e)); }
    const float* x = (const float*)d_in[0];
    const float *mnorm = (const float*)d_in[5], *lscale = (const float*)d_in[12];
    const float *conv_w = (const float*)d_in[14], *conv_b = (const float*)d_in[15];
    const float *ln_mix_g = (const float*)d_in[17], *ln_mix_b = (const float*)d_in[18], *ln_ffn_g = (const float*)d_in[19], *ln_ffn_b = (const float*)d_in[20];
    float* out = (float*)d_out; unsigned char* ws = (unsigned char*)d_ws;
    const WsPtrs P = ws_ptrs(ws);
    auto nblk = [](size_t n, int b) { return dim3((unsigned)((n + b - 1) / b)); };
    Args a{}; for (int i = 0; i < 21; ++i) a.in[i] = d_in[i]; a.out = out; a.ws = ws;
    for (int ph = 0; ph < 3; ++ph) { a.ph_lo = ph; a.ph_hi = ph + 1; mk_fwd<false><<<dim3(256), dim3(MK_THREADS), MK_LDS, stream>>>(a); }
    k_attn_fast<<<dim3(256), dim3(512), att::LDS_BYTES, stream>>>(P.QA, P.KVB, P.KR, P.Y);
    k_mlstm_fast<<<dim3(NB * 4), dim3(512), mls::LDS_NEED, stream>>>(P.H1, P.GI, P.GF, mnorm, P.Y);
    for (int ph = 3; ph < 17; ++ph) { a.ph_lo = ph; a.ph_hi = ph + 1; mk_fwd<false><<<dim3(256), dim3(MK_THREADS), MK_LDS, stream>>>(a); }
}
```

```cpp
#include <hip/hip_runtime.h>
#include <cstdio>
#include <cstdint>

typedef unsigned short bf16_t;
typedef short bf16x8 __attribute__((ext_vector_type(8)));
typedef float f32x4 __attribute__((ext_vector_type(4)));

constexpr int NB = 8, SEQ = 4096, DM = 1024, T = NB * SEQ;
constexpr int IN_COLS = 2504, NIN = 2560;
constexpr int FF = 2816, FF2 = 5632;
constexpr float ALPHA = 1.4142135623730951f;
constexpr float LN_EPS = 1e-5f, RMS_EPS = 1e-6f;

constexpr size_t MiB = 1u << 20;
constexpr size_t WS_WIN = 0, WS_WUQ = 5 * MiB, WS_WUKV = 6 * MiB, WS_WOUT = 7 * MiB, WS_WPOOL = 9 * MiB, WS_WUP = 10 * MiB, WS_WDN = 32 * MiB;
constexpr size_t WS_CTL = 44 * MiB, WS_COS = 46 * MiB, WS_SIN = 50 * MiB, WS_GI = 54 * MiB, WS_GF = 54 * MiB + 512 * 1024, WS_SSQ = 55 * MiB;
constexpr size_t WS_KR = 56 * MiB, WS_CKV = 60 * MiB, WS_CQ = 68 * MiB, WS_XNB = 84 * MiB, WS_H1 = 148 * MiB, WS_KVB = 276 * MiB, WS_QA = 340 * MiB, WS_Y = 388 * MiB;
constexpr size_t WS_HS = 388 * MiB;
constexpr size_t WS_YS_A = 148 * MiB;
constexpr size_t WS_G = 148 * MiB;
constexpr size_t WS_UH = 324 * MiB;
constexpr size_t WS_YS_B = 324 * MiB;
constexpr size_t WS_PB = 148 * MiB;
constexpr size_t WS_YS_C = 212 * MiB;
constexpr size_t WS_END = 512 * MiB;

__device__ __forceinline__ unsigned f2bf(float f) { unsigned u = __builtin_bit_cast(unsigned, f); return (u + 0x7fffu + ((u >> 16) & 1u)) >> 16; }
__device__ __forceinline__ float bf2f(bf16_t b) { return __builtin_bit_cast(float, ((unsigned)b) << 16); }
__device__ __forceinline__ float wave_sum(float v) {
#pragma unroll
    for (int o = 1; o < 64; o <<= 1) v += __shfl_xor(v, o);
    return v;
}
__device__ __forceinline__ float sigmoidf_(float x) { return 1.f / (1.f + __expf(-x)); }

__host__ __device__ __forceinline__ int rope_dim_of_slot(int p) { const int g = p >> 3, i = p & 7; return (i < 4) ? (4 * g + i) : (32 + 4 * g + (i - 4)); }
__device__ __forceinline__ void sincos_reduced(double r, double& s, double& c) {
    const double r2 = r * r;
    double ss = 1.0, cc = 1.0;
#pragma unroll
    for (int n = 27; n >= 3; n -= 2) ss = 1.0 - ss * r2 / (double)((n) * (n - 1));
#pragma unroll
    for (int n = 26; n >= 2; n -= 2) cc = 1.0 - cc * r2 / (double)((n) * (n - 1));
    s = r * ss; c = cc;
}
namespace pg8 {
#define PG8_LAS __attribute__((address_space(3)))
typedef unsigned u32x4 __attribute__((ext_vector_type(4)));
typedef unsigned u32x2 __attribute__((ext_vector_type(2)));
constexpr int BM = 256, BK = 64, HALF = 128, HTB = HALF * BK * 2  , STAGE_BYTES = 8 * HTB, NXCD = 8, WGM = 8;
__host__ __device__ __forceinline__ int lds_byte(int r, int c) { const int st = (r >> 4) * 2 + (c >> 5), rr = r & 15, cc = c & 31, ob = rr * 64 + cc * 2; return st * 1024 + (ob ^ (((ob >> 9) & 1) << 5)); }
__host__ __device__ __forceinline__ void stage_rc(int b, int& R, int& C) { const int st = b / 1024, sb = b % 1024, swz = sb ^ (((sb >> 9) & 1) << 5); R = (st >> 1) * 16 + swz / 64; C = (st & 1) * 32 + (swz % 64) / 2; }
__host__ __device__ __forceinline__ int perm32(int rho) { const int n = rho >> 4, i = rho & 15; return 8 * (i >> 2) + 4 * n + (i & 3); }

struct Unit { int pm, pn; };
struct Gemm { const bf16_t* A; const bf16_t* Bt; int K, lda, ldb, a_pn_off; };
struct StaticOrder {
    int nM, nN, nwg, G, c;
    __host__ __device__ void init(int nM_, int nN_, int G_, int c_) { nM = nM_; nN = nN_; nwg = nM * nN; G = G_; c = c_; }
    __host__ __device__ bool next(int i, Unit& u) const {
        const long L = (long)i * G + c; if (L >= nwg) return false;
        int wgid = (int)L; { const int q = nwg / NXCD, r = nwg % NXCD, xcd = wgid % NXCD, off = wgid / NXCD; wgid = (xcd < r ? xcd * (q + 1) : r * (q + 1) + (xcd - r) * q) + off; }
        const int nig = WGM * nN, gid = wgid / nig, fm = gid * WGM, gsz = (nM - fm) < WGM ? (nM - fm) : WGM;
        u.pm = fm + ((wgid % nig) % gsz); u.pn = (wgid % nig) / gsz; return true;
    }
    __device__ __forceinline__ void a_ready(const Unit&) const {}
    __device__ __forceinline__ void done(const Unit&) const {}
};
struct AMapStd  { static constexpr int HROWS = 128; __device__ static __forceinline__ int slot_row(int R) { return R; } __device__ static __forceinline__ long tile_row0(int pm) { return 256L * pm; } };
struct AMapConv { static constexpr int HROWS = 64;  __device__ static __forceinline__ int slot_row(int R) { return (R >> 6) * 126 + (R & 63); } __device__ static __forceinline__ long tile_row0(int pm) { return 252L * pm - 2; } };

__device__ __forceinline__ unsigned cvt_pk_bf16(float lo, float hi) { unsigned r; asm volatile("v_cvt_pk_bf16_f32 %0, %1, %2" : "=v"(r) : "v"(lo), "v"(hi)); return r; }
__device__ __forceinline__ u32x4 pack8(const f32x4& a, const f32x4& b) { u32x4 w; w.x = cvt_pk_bf16(a[0], a[1]); w.y = cvt_pk_bf16(a[2], a[3]); w.z = cvt_pk_bf16(b[0], b[1]); w.w = cvt_pk_bf16(b[2], b[3]); return w; }

template <class Epi, class Sched, class AMap, bool ALIGN_EPI, bool SP2>
__device__ __forceinline__ void gemm_phase(PG8_LAS unsigned char* lds, const Gemm g, const Sched& S, const Epi& E, int tid_in) {
    int tid_ = tid_in; asm volatile("" : "+v"(tid_));
    const int tid = tid_, wid = __builtin_amdgcn_readfirstlane(tid >> 6), lane = tid & 63, wr = wid >> 2, wc = wid & 3, fr = lane & 15, fq = lane >> 4;
    const int K = g.K, nt = K / BK;
    unsigned voffA[2], voffB[2];
#pragma unroll
    for (int i = 0; i < 2; ++i) { int R, C; stage_rc(tid * 16 + i * 8192, R, C); const int Rb = Epi::PERM ? ((R & ~31) + perm32(R & 31)) : R;
        voffA[i] = (unsigned)(AMap::slot_row(R) * g.lda + C) * 2u; voffB[i] = (unsigned)(Rb * g.ldb + C) * 2u; }
    const size_t kstep = (size_t)(BK * 2);
    const size_t hstepA = (size_t)AMap::HROWS * g.lda * 2, hstepB = (size_t)HALF * g.ldb * 2, tstepB = 2 * hstepB;
    const unsigned ldsw = (unsigned)wid * 1024u;
    const int aoff = lds_byte(wr * 64 + fr, fq * 8), boff = lds_byte(wc * 32 + fr, fq * 8);
#define PG8_SA(b, h) (((b) * 2 + (h)) * HTB)
#define PG8_SB(b, h) ((4 + (b) * 2 + (h)) * HTB)
#define PG8_STAGE(bufoff, gbase, voff) do { _Pragma("unroll") for (int _i = 0; _i < 2; ++_i) \
        __builtin_amdgcn_global_load_lds((const unsigned*)((const char*)(gbase) + (voff)[_i]), (PG8_LAS unsigned*)(lds + (bufoff) + ldsw + _i * 8192), 16, 0, 0); } while (0)
#define PG8_LDA(dst, b, h) do { _Pragma("unroll") for (int m = 0; m < 4; ++m) _Pragma("unroll") for (int k = 0; k < 2; ++k) dst[m][k] = *(const PG8_LAS bf16x8*)(lds + PG8_SA(b, h) + aoff + m * 2048 + k * 1024); } while (0)
#define PG8_LDB(dst, b, h) do { _Pragma("unroll") for (int n = 0; n < 2; ++n) _Pragma("unroll") for (int k = 0; k < 2; ++k) dst[n][k] = *(const PG8_LAS bf16x8*)(lds + PG8_SB(b, h) + boff + n * 2048 + k * 1024); } while (0)
#define PG8_MMA(ai, bj, At, Bt) do { __builtin_amdgcn_s_setprio(1); _Pragma("unroll") for (int m = 0; m < 4; ++m) _Pragma("unroll") for (int n = 0; n < 2; ++n) _Pragma("unroll") for (int k = 0; k < 2; ++k) \
        acc[ai][bj][m][n] = __builtin_amdgcn_mfma_f32_16x16x32_bf16(Bt[n][k], At[m][k], acc[ai][bj][m][n], 0, 0, 0); __builtin_amdgcn_s_setprio(0); } while (0)
#define PG8_WAIT_V(n) asm volatile("s_waitcnt vmcnt(" #n ")" ::: "memory")
#define PG8_WAIT_L(n) asm volatile("s_waitcnt lgkmcnt(" #n ")" ::: "memory")
#define PG8_BAR __builtin_amdgcn_s_barrier()
#define PG8_SCHED __builtin_amdgcn_sched_barrier(0)
#define PG8_ABASE(u_) ((const char*)g.A + (AMap::tile_row0((u_).pm) * (long)g.lda) * 2 + (long)(u_).pn * g.a_pn_off)
#define PG8_BBASE(u_) ((const char*)g.Bt + (size_t)(u_).pn * tstepB)
    Unit cur, nxt; int ui = 0;
    if (!S.next(0, cur)) return;
    f32x4 acc[2][2][4][2];
#pragma unroll
    for (int a = 0; a < 2; ++a)
#pragma unroll
        for (int b = 0; b < 2; ++b)
#pragma unroll
            for (int m = 0; m < 4; ++m)
#pragma unroll
                for (int n = 0; n < 2; ++n) acc[a][b][m][n] = (f32x4){0.f, 0.f, 0.f, 0.f};
    bf16x8 At[4][2], B0[2][2], B1[2][2];
    const char* cA = PG8_ABASE(cur); const char* cB = PG8_BBASE(cur);
    S.a_ready(cur);
    if constexpr (SP2) {
        PG8_STAGE(PG8_SB(0, 0), cB, voffB); PG8_STAGE(PG8_SB(0, 1), cB + hstepB, voffB); PG8_STAGE(PG8_SA(0, 0), cA, voffA); PG8_STAGE(PG8_SA(0, 1), cA + hstepA, voffA);
        if (wr == 1) PG8_BAR;
        PG8_WAIT_V(2); PG8_BAR;
        PG8_STAGE(PG8_SB(1, 0), cB + kstep, voffB); PG8_STAGE(PG8_SA(1, 0), cA + kstep, voffA); PG8_STAGE(PG8_SB(1, 1), cB + hstepB + kstep, voffB);
        PG8_WAIT_V(6); PG8_BAR;
    } else {
        PG8_STAGE(PG8_SB(0, 0), cB, voffB); PG8_STAGE(PG8_SA(0, 0), cA, voffA); PG8_STAGE(PG8_SB(0, 1), cB + hstepB, voffB); PG8_STAGE(PG8_SA(0, 1), cA + hstepA, voffA);
        if (wr == 1) PG8_BAR;
        PG8_WAIT_V(4); PG8_BAR;
        PG8_STAGE(PG8_SB(1, 0), cB + kstep, voffB); PG8_STAGE(PG8_SA(1, 0), cA + kstep, voffA); PG8_STAGE(PG8_SB(1, 1), cB + hstepB + kstep, voffB);
        PG8_WAIT_V(6); PG8_BAR;
    }
    for (;;) {
        const bool has_next = S.next(ui + 1, nxt);
        const char* nA = has_next ? PG8_ABASE(nxt) : cA; const char* nB = has_next ? PG8_BBASE(nxt) : cB;
        for (int t = 0; t < nt; t += 2) {
            const bool last = (t == nt - 2);
            const char* a1 = cA + (size_t)(t + 1) * kstep;
            const char* a2 = last ? nA : cA + (size_t)(t + 2) * kstep; const char* b2 = last ? nB : cB + (size_t)(t + 2) * kstep;
            const char* a3 = a2 + kstep; const char* b3 = b2 + kstep;
            if (last && has_next) S.a_ready(nxt);
            if constexpr (SP2) {
            PG8_LDB(B0, 0, 0); PG8_LDB(B1, 0, 1); PG8_SCHED; PG8_LDA(At, 0, 0); PG8_STAGE(PG8_SA(1, 1), a1 + hstepA, voffA);
            PG8_WAIT_V(8); PG8_WAIT_L(0); PG8_BAR; PG8_MMA(0, 0, At, B0); PG8_MMA(0, 1, At, B1); PG8_BAR; PG8_SCHED;
            PG8_LDA(At, 0, 1); PG8_STAGE(PG8_SB(0, 0), b2, voffB); PG8_STAGE(PG8_SB(0, 1), b2 + hstepB, voffB); PG8_STAGE(PG8_SA(0, 0), a2, voffA);
            PG8_WAIT_V(8); PG8_WAIT_L(0); PG8_BAR; PG8_MMA(1, 0, At, B0); PG8_MMA(1, 1, At, B1); PG8_BAR; PG8_SCHED;
            PG8_LDB(B0, 1, 0); PG8_LDB(B1, 1, 1); PG8_SCHED; PG8_LDA(At, 1, 0); PG8_STAGE(PG8_SA(0, 1), a2 + hstepA, voffA);
            PG8_WAIT_V(8); PG8_WAIT_L(0); PG8_BAR; PG8_MMA(0, 0, At, B0); PG8_MMA(0, 1, At, B1); PG8_BAR; PG8_SCHED;
            PG8_LDA(At, 1, 1); PG8_STAGE(PG8_SB(1, 0), b3, voffB); PG8_STAGE(PG8_SB(1, 1), b3 + hstepB, voffB); PG8_STAGE(PG8_SA(1, 0), a3, voffA);
            PG8_WAIT_V(8); PG8_WAIT_L(0); PG8_BAR; PG8_MMA(1, 0, At, B0); PG8_MMA(1, 1, At, B1); PG8_BAR; PG8_SCHED;
            } else {
            PG8_LDB(B0, 0, 0); PG8_SCHED; PG8_LDA(At, 0, 0); PG8_STAGE(PG8_SA(1, 1), a1 + hstepA, voffA);
            PG8_WAIT_L(8); PG8_BAR; PG8_WAIT_L(0); PG8_MMA(0, 0, At, B0); PG8_BAR; PG8_SCHED;
            PG8_LDB(B1, 0, 1); PG8_STAGE(PG8_SB(0, 0), b2, voffB);
            PG8_BAR; PG8_WAIT_L(0); PG8_MMA(0, 1, At, B1); PG8_BAR;
            PG8_LDA(At, 0, 1); PG8_STAGE(PG8_SA(0, 0), a2, voffA);
            PG8_BAR; PG8_WAIT_L(0); PG8_MMA(1, 0, At, B0); PG8_BAR; PG8_SCHED;
            PG8_STAGE(PG8_SB(0, 1), b2 + hstepB, voffB);
            PG8_WAIT_V(6); PG8_BAR; PG8_MMA(1, 1, At, B1); PG8_BAR;
            PG8_LDB(B0, 1, 0); PG8_SCHED; PG8_LDA(At, 1, 0); PG8_STAGE(PG8_SA(0, 1), a2 + hstepA, voffA);
            PG8_WAIT_L(8); PG8_BAR; PG8_WAIT_L(0); PG8_MMA(0, 0, At, B0); PG8_BAR; PG8_SCHED;
            PG8_LDB(B1, 1, 1); PG8_STAGE(PG8_SB(1, 0), b3, voffB);
            PG8_BAR; PG8_WAIT_L(0); PG8_MMA(0, 1, At, B1); PG8_BAR;
            PG8_LDA(At, 1, 1); PG8_STAGE(PG8_SA(1, 0), a3, voffA);
            PG8_BAR; PG8_WAIT_L(0); PG8_MMA(1, 0, At, B0); PG8_BAR; PG8_SCHED;
            PG8_STAGE(PG8_SB(1, 1), b3 + hstepB, voffB);
            PG8_WAIT_V(6); PG8_BAR; PG8_MMA(1, 1, At, B1); PG8_BAR;
            }
        }
        if constexpr (ALIGN_EPI) { if (wr == 0) PG8_BAR; }
        if constexpr (!Epi::AFTER_DRAIN) { E(acc, cur, wr, wc, fr, fq); S.done(cur); }
        if (!has_next) break;
#pragma unroll
        for (int a = 0; a < 2; ++a)
#pragma unroll
            for (int b = 0; b < 2; ++b)
#pragma unroll
                for (int m = 0; m < 4; ++m)
#pragma unroll
                    for (int n = 0; n < 2; ++n) acc[a][b][m][n] = (f32x4){0.f, 0.f, 0.f, 0.f};
        cur = nxt; cA = nA; cB = nB; ++ui;
        if constexpr (ALIGN_EPI) { if (wr == 1) PG8_BAR; }
    }
    PG8_WAIT_V(0);
    if constexpr (!ALIGN_EPI) { if (wr == 0) PG8_BAR; }
    PG8_BAR;
    if constexpr (Epi::AFTER_DRAIN) { E.fused(acc, cur, wr, wc, fr, fq, lds, wid, lane); S.done(cur); }
#undef PG8_SA
#undef PG8_SB
#undef PG8_STAGE
#undef PG8_LDA
#undef PG8_LDB
#undef PG8_MMA
#undef PG8_WAIT_V
#undef PG8_WAIT_L
#undef PG8_BAR
#undef PG8_SCHED
#undef PG8_ABASE
#undef PG8_BBASE
}

struct EpiWin { static constexpr bool PERM = true, AFTER_DRAIN = false;
    bf16_t* H1; bf16_t* CQ; bf16_t* CKV; bf16_t* KR; float* SSQ; float* GI; float* GF; const float* COS; const float* SIN; const float* b_i; const float* b_f;
    __device__ __forceinline__ void operator()(const f32x4 (&acc)[2][2][4][2], const Unit& u, int wr, int wc, int fr, int fq) const {
        const int row0 = u.pm * BM + wr * 64 + fr;
        if (u.pn < 8) {
#pragma unroll
            for (int ai = 0; ai < 2; ++ai)
#pragma unroll
                for (int m = 0; m < 4; ++m) { bf16_t* rowp = H1 + (size_t)(row0 + ai * HALF + m * 16) * 2048 + u.pn * BM + wc * 32 + 8 * fq;
#pragma unroll
                    for (int bj = 0; bj < 2; ++bj) *(u32x4*)(rowp + bj * HALF) = pack8(acc[ai][bj][m][0], acc[ai][bj][m][1]); }
        } else if (u.pn == 8) {
#pragma unroll
            for (int ai = 0; ai < 2; ++ai)
#pragma unroll
                for (int m = 0; m < 4; ++m) { const size_t row = (size_t)(row0 + ai * HALF + m * 16); float s = 0.f;
#pragma unroll
                    for (int bj = 0; bj < 2; ++bj)
#pragma unroll
                        for (int n = 0; n < 2; ++n) { const f32x4 x = acc[ai][bj][m][n]; s += (x[0] * x[0] + x[1] * x[1]) + (x[2] * x[2] + x[3] * x[3]); }
                    s += __shfl_xor(s, 16); s += __shfl_xor(s, 32);
                    if (fq == 0) SSQ[row * 8 + wc] = s;
#pragma unroll
                    for (int bj = 0; bj < 2; ++bj) *(u32x4*)(CQ + row * 256 + bj * HALF + wc * 32 + 8 * fq) = pack8(acc[ai][bj][m][0], acc[ai][bj][m][1]); }
        } else {
            f32x4 bi = *(const f32x4*)b_i, bf = *(const f32x4*)b_f;
#pragma unroll
            for (int ai = 0; ai < 2; ++ai)
#pragma unroll
                for (int m = 0; m < 4; ++m) { const size_t row = (size_t)(row0 + ai * HALF + m * 16);
                    const f32x4 x0 = acc[ai][0][m][0], x1 = acc[ai][0][m][1];
                    float s = ((x0[0] * x0[0] + x0[1] * x0[1]) + (x0[2] * x0[2] + x0[3] * x0[3])) + ((x1[0] * x1[0] + x1[1] * x1[1]) + (x1[2] * x1[2] + x1[3] * x1[3]));
                    s += __shfl_xor(s, 16); s += __shfl_xor(s, 32);
                    if (fq == 0) SSQ[row * 8 + 4 + wc] = s;
                    *(u32x4*)(CKV + row * 128 + wc * 32 + 8 * fq) = pack8(x0, x1);
                    const f32x4 a = acc[ai][1][m][0], b = acc[ai][1][m][1];
                    if (wc < 2) { const int g = 4 * wc + fq; const f32x4 c = *(const f32x4*)(COS + row * 32 + 4 * g), sn = *(const f32x4*)(SIN + row * 32 + 4 * g);
                        *(u32x4*)(KR + row * 64 + 8 * g) = pack8(a * c - b * sn, b * c + a * sn); }
                    else if (wc == 2 && fq == 0) { *(f32x4*)(GI + row * 4) = a + bi; *(f32x4*)(GF + row * 4) = b + bf; } }
        }
    }
};
struct EpiUq { static constexpr bool PERM = true, AFTER_DRAIN = false;
    bf16_t* QA; const float* SSQ; const float* COS; const float* SIN;
    __device__ __forceinline__ void operator()(const f32x4 (&acc)[2][2][4][2], const Unit& u, int wr, int wc, int fr, int fq) const {
        const int row0 = u.pm * BM + wr * 64 + fr;
#pragma unroll
        for (int ai = 0; ai < 2; ++ai)
#pragma unroll
            for (int m = 0; m < 4; ++m) { const size_t row = (size_t)(row0 + ai * HALF + m * 16); const f32x4 s4 = *(const f32x4*)(SSQ + row * 8);
                const float rs = rsqrtf(((s4[0] + s4[1]) + (s4[2] + s4[3])) * (1.f / 256.f) + RMS_EPS);
#pragma unroll
                for (int bj = 0; bj < 2; ++bj) { const int c = u.pn * BM + bj * HALF + wc * 32 + 8 * fq, d = c % 192;
                    f32x4 v0 = acc[ai][bj][m][0] * rs, v1 = acc[ai][bj][m][1] * rs;
                    if (d >= 128) { const int g = (d - 128) >> 3; const f32x4 cc = *(const f32x4*)(COS + row * 32 + 4 * g), sn = *(const f32x4*)(SIN + row * 32 + 4 * g);
                        const f32x4 o0 = v0 * cc - v1 * sn, o1 = v1 * cc + v0 * sn; v0 = o0; v1 = o1; }
                    *(u32x4*)(QA + row * 768 + c) = pack8(v0, v1); }
                asm volatile("" ::: "memory"); }
    }
};
struct EpiUkv { static constexpr bool PERM = true, AFTER_DRAIN = false;
    bf16_t* KVB; const float* SSQ;
    __device__ __forceinline__ void operator()(const f32x4 (&acc)[2][2][4][2], const Unit& u, int wr, int wc, int fr, int fq) const {
        const int row0 = u.pm * BM + wr * 64 + fr;
#pragma unroll
        for (int ai = 0; ai < 2; ++ai)
#pragma unroll
            for (int m = 0; m < 4; ++m) { const size_t row = (size_t)(row0 + ai * HALF + m * 16); const f32x4 s4 = *(const f32x4*)(SSQ + row * 8 + 4);
                const float rs = rsqrtf(((s4[0] + s4[1]) + (s4[2] + s4[3])) * (1.f / 128.f) + RMS_EPS);
#pragma unroll
                for (int bj = 0; bj < 2; ++bj) *(u32x4*)(KVB + row * 1024 + u.pn * BM + bj * HALF + wc * 32 + 8 * fq) = pack8(acc[ai][bj][m][0] * rs, acc[ai][bj][m][1] * rs);
                asm volatile("" ::: "memory"); }
    }
};

struct EpiF32 { static constexpr bool PERM = false, AFTER_DRAIN = false;
    float* C; const float* cscale; int ldc; int pad;
    __device__ __forceinline__ void operator()(const f32x4 (&acc)[2][2][4][2], const Unit& u, int wr, int wc, int fr, int fq) const {
        const int row0 = u.pm * BM + wr * 64 + fr, col0 = u.pn * BM + wc * 32 + 4 * fq;
        f32x4 sc[2][2];
#pragma unroll
        for (int bj = 0; bj < 2; ++bj)
#pragma unroll
            for (int n = 0; n < 2; ++n) sc[bj][n] = cscale ? *(const f32x4*)(cscale + col0 + bj * HALF + n * 16) : (f32x4){1.f, 1.f, 1.f, 1.f};
#pragma unroll
        for (int ai = 0; ai < 2; ++ai)
#pragma unroll
            for (int m = 0; m < 4; ++m) { float* rowp = C + (size_t)(row0 + ai * HALF + m * 16) * ldc + col0;
#pragma unroll
                for (int bj = 0; bj < 2; ++bj)
#pragma unroll
                    for (int n = 0; n < 2; ++n) *(f32x4*)(rowp + bj * HALF + n * 16) = acc[ai][bj][m][n] * sc[bj][n]; }
    }
};
template <int N> __device__ __forceinline__ float dpp_rows_back(float cur, float prevblk) {
    const int old = __builtin_amdgcn_update_dpp(0, __builtin_bit_cast(int, prevblk), 0x100 + (16 - N), 0xf, 0xf, true);
    return __builtin_bit_cast(float, __builtin_amdgcn_update_dpp(old, __builtin_bit_cast(int, cur), 0x110 + N, 0xf, 0xf, false));
}
template <int N> __device__ __forceinline__ f32x4 dpp_rows_back4(const f32x4& cur, const f32x4& prevblk) {
    f32x4 r; r[0] = dpp_rows_back<N>(cur[0], prevblk[0]); r[1] = dpp_rows_back<N>(cur[1], prevblk[1]); r[2] = dpp_rows_back<N>(cur[2], prevblk[2]); r[3] = dpp_rows_back<N>(cur[3], prevblk[3]); return r; }
struct EpiConv { static constexpr bool PERM = true, AFTER_DRAIN = false;
    bf16_t* G; const float* cw; const float* cb;
    __device__ __forceinline__ void operator()(const f32x4 (&acc)[2][2][4][2], const Unit& u, int wr, int wc, int fr, int fq) const {
        const long rowb = 252L * u.pm - 2 + 126 * wr;
        const int cg = 128 * u.pn + 32 * wc + 8 * fq;
        const bool has_start = ((rowb + 127) >> 12) != ((rowb - 1) >> 12);
#pragma unroll
        for (int n = 0; n < 2; ++n) {
            const int c = cg + 4 * n;
            const f32x4 wg0 = *(const f32x4*)(cw + c), wg1 = *(const f32x4*)(cw + FF2 + c), wg2 = *(const f32x4*)(cw + 2 * FF2 + c), bg = *(const f32x4*)(cb + c);
            const f32x4 wv0 = *(const f32x4*)(cw + FF + c), wv1 = *(const f32x4*)(cw + FF2 + FF + c), wv2 = *(const f32x4*)(cw + 2 * FF2 + FF + c), bv = *(const f32x4*)(cb + FF + c);
            f32x4 pg = acc[0][0][0][n], pv = acc[0][1][0][n];
#pragma unroll
            for (int ai = 0; ai < 2; ++ai)
#pragma unroll
                for (int m = 0; m < 4; ++m) {
                    const f32x4 ug = acc[ai][0][m][n], uv = acc[ai][1][m][n];
                    f32x4 g1 = dpp_rows_back4<1>(ug, pg), g2 = dpp_rows_back4<2>(ug, pg), v1 = dpp_rows_back4<1>(uv, pv), v2 = dpp_rows_back4<2>(uv, pv);
                    pg = ug; pv = uv;
                    const int j = 64 * ai + 16 * m + fr; const long row = rowb + j;
                    if (has_start) { const int sq = (int)(row & 4095); const f32x4 z = {0.f, 0.f, 0.f, 0.f};
                        if (sq == 0) { g1 = z; v1 = z; } if (sq <= 1) { g2 = z; v2 = z; } }
                    const f32x4 gate = bg + wg0 * g2 + wg1 * g1 + wg2 * ug, val = bv + wv0 * v2 + wv1 * v1 + wv2 * uv;
                    f32x4 o;
#pragma unroll
                    for (int i = 0; i < 4; ++i) o[i] = gate[i] * __builtin_amdgcn_rcpf(1.f + __expf(-gate[i])) * val[i];
                    if (j >= 2 && row < T) { u32x2 w; w.x = cvt_pk_bf16(o[0], o[1]); w.y = cvt_pk_bf16(o[2], o[3]); *(u32x2*)(G + (size_t)row * FF + c) = w; }
                }
        }
    }
};
}

#define LAS __attribute__((address_space(3)))
typedef unsigned v4u __attribute__((ext_vector_type(4)));
constexpr int MK_THREADS = 512, MK_LDS = 139264, MK_QWORD = 139248;
struct Args { const void* in[21]; float* out; unsigned char* ws; int ph_lo, ph_hi; };
__device__ __forceinline__ unsigned pk2(float lo, float hi) { return f2bf(lo) | (f2bf(hi) << 16); }

struct MapId  { __device__ int src(int n) const { return n; } __device__ float scale(int) const { return 1.f; } };
struct MapWin { __device__ int src(int n) const { if (n < 2048) return n; if (n < 2304) return 2056 + (n - 2048); if (n < 2432) return 2312 + (n - 2304); if (n < 2496) return 2440 + rope_dim_of_slot(n - 2432);
                    if (n < 2500) return 2048 + (n - 2496); if (n < 2504) return 2052 + (n - 2500); return -1; }
                __device__ float scale(int n) const { return (n >= 512 && n < 1024) ? 0.08838834764831845f : 1.f; } };
struct MapUq  { __device__ int src(int n) const { const int h = n / 192, d = n % 192; return h * 192 + (d < 128 ? d : 128 + rope_dim_of_slot(d - 128)); } __device__ float scale(int) const { return 1.f; } };
struct MapWup { __device__ int src(int p) const { const int pn = p >> 8, r = p & 255; return ((r >> 7) ? FF : 0) + 128 * pn + (r & 127); } __device__ float scale(int) const { return 1.f; } };
template <class Map>
__device__ __forceinline__ void tr_item(const float* __restrict__ W, int Nsrc, int K, bf16_t* __restrict__ WT, const float* __restrict__ kscale, LAS float* scr, int item, int nblk, int lane, const Map map) {
    const int kb = item / nblk, nb = item % nblk, k0 = 64 * kb, n0 = 32 * nb;
    const int oc = map.src(n0 + (lane & 31)); const float cs = map.scale(n0 + (lane & 31));
#pragma unroll 8
    for (int i = 0; i < 32; ++i) { const int kk = 2 * i + (lane >> 5); float v = (oc >= 0) ? W[(size_t)(k0 + kk) * Nsrc + oc] * cs : 0.f; if (kscale) v *= kscale[k0 + kk]; scr[kk * 33 + (lane & 31)] = v; }
    asm volatile("s_waitcnt lgkmcnt(0)" ::: "memory");
    const int c = lane & 7;
#pragma unroll
    for (int j = 0; j < 4; ++j) { const int n = (lane >> 3) + 8 * j; const LAS float* s = scr + (8 * c) * 33 + n;
        v4u o; o.x = pk2(s[0 * 33], s[1 * 33]); o.y = pk2(s[2 * 33], s[3 * 33]); o.z = pk2(s[4 * 33], s[5 * 33]); o.w = pk2(s[6 * 33], s[7 * 33]);
        *(v4u*)(WT + (size_t)(n0 + n) * K + k0 + 8 * c) = o; }
    asm volatile("s_waitcnt lgkmcnt(0)" ::: "memory");
}
struct WsPtrs { bf16_t *Win_t, *Wuq_t, *Wukv_t, *Wout_t, *Wpool_t, *Wup_t, *Wdn_t, *KR, *CKV, *CQ, *XNB, *H1, *KVB, *QA, *Y; float *COS, *SIN, *GI, *GF, *SSQ; };
__host__ __device__ __forceinline__ WsPtrs ws_ptrs(unsigned char* ws) { WsPtrs p;
    p.Win_t = (bf16_t*)(ws + WS_WIN); p.Wuq_t = (bf16_t*)(ws + WS_WUQ); p.Wukv_t = (bf16_t*)(ws + WS_WUKV); p.Wout_t = (bf16_t*)(ws + WS_WOUT); p.Wpool_t = (bf16_t*)(ws + WS_WPOOL); p.Wup_t = (bf16_t*)(ws + WS_WUP); p.Wdn_t = (bf16_t*)(ws + WS_WDN);
    p.KR = (bf16_t*)(ws + WS_KR); p.CKV = (bf16_t*)(ws + WS_CKV); p.CQ = (bf16_t*)(ws + WS_CQ); p.XNB = (bf16_t*)(ws + WS_XNB); p.H1 = (bf16_t*)(ws + WS_H1); p.KVB = (bf16_t*)(ws + WS_KVB); p.QA = (bf16_t*)(ws + WS_QA); p.Y = (bf16_t*)(ws + WS_Y);
    p.COS = (float*)(ws + WS_COS); p.SIN = (float*)(ws + WS_SIN); p.GI = (float*)(ws + WS_GI); p.GF = (float*)(ws + WS_GF); p.SSQ = (float*)(ws + WS_SSQ); return p; }

__device__ __forceinline__ void p0_prologue(const Args& a, const WsPtrs& P, LAS unsigned char* lds, int tid_in) {
    int tid_ = tid_in; asm volatile("" : "+v"(tid_));
    const int tid = tid_, lane = tid & 63, wave = __builtin_amdgcn_readfirstlane(tid >> 6);
    LAS float* scr = (LAS float*)(lds + wave * 16384);
    const int gw = blockIdx.x * 8 + wave, NGW = gridDim.x * 8;
    const float *w_in = (const float*)a.in[2], *qnorm = (const float*)a.in[6], *kvnorm = (const float*)a.in[7], *w_uq = (const float*)a.in[8], *w_ukv = (const float*)a.in[9], *w_out = (const float*)a.in[10], *pool_w = (const float*)a.in[11];
    const float *w_up = (const float*)a.in[13], *w_dn = (const float*)a.in[16];
    constexpr int I_IN = 16 * 80, I_UQ = 4 * 24, I_UKV = 2 * 32, I_OUT = 16 * 32, I_POOL = 4 * 8, I_UP = 16 * 176, I_DN = 44 * 32;
    constexpr int NITEMS = I_IN + I_UQ + I_UKV + I_OUT + 4 * I_POOL + 2 * I_UP + 2 * I_DN;
    for (int it = gw; it < NITEMS; it += NGW) {
        int r = it;
        if (r < I_IN) { tr_item(w_in, IN_COLS, DM, P.Win_t, nullptr, scr, r, 80, lane, MapWin{}); continue; } r -= I_IN;
        if (r < I_UQ) { tr_item(w_uq, 768, 256, P.Wuq_t, qnorm, scr, r, 24, lane, MapUq{}); continue; } r -= I_UQ;
        if (r < I_UKV) { tr_item(w_ukv, 1024, 128, P.Wukv_t, kvnorm, scr, r, 32, lane, MapId{}); continue; } r -= I_UKV;
        if (r < I_OUT) { tr_item(w_out, DM, DM, P.Wout_t, nullptr, scr, r, 32, lane, MapId{}); continue; } r -= I_OUT;
        if (r < 4 * I_POOL) { const int g = r / I_POOL; tr_item(pool_w + (size_t)g * 65536, 256, 256, P.Wpool_t + (size_t)g * 65536, nullptr, scr, r % I_POOL, 8, lane, MapId{}); continue; } r -= 4 * I_POOL;
        if (r < 2 * I_UP) { const int l = r / I_UP; tr_item(w_up + (size_t)l * DM * FF2, FF2, DM, P.Wup_t + (size_t)l * FF2 * DM, nullptr, scr, r % I_UP, 176, lane, MapWup{}); continue; } r -= 2 * I_UP;
        { const int l = r / I_DN; tr_item(w_dn + (size_t)l * FF * DM, DM, FF, P.Wdn_t + (size_t)l * DM * FF, nullptr, scr, r % I_DN, 32, lane, MapId{}); }
    }
    const size_t gt = (size_t)blockIdx.x * MK_THREADS + tid, NGT = (size_t)gridDim.x * MK_THREADS;
    const float* x = (const float*)a.in[0];
    for (size_t i = gt; i < (size_t)T * DM / 4; i += NGT) { const f32x4 v = ((const f32x4*)x)[i]; uint2 o; o.x = pk2(v[0], v[1]); o.y = pk2(v[2], v[3]); ((uint2*)P.XNB)[i] = o; }
    const int* pos = (const int*)a.in[1];
    for (size_t i = gt; i < (size_t)T * 32; i += NGT) { const int t = (int)(i >> 5), r = (int)(i & 31);
        const float inv_freq = (float)pow(10000.0, -(double)r / 32.0); const float ang = (float)pos[t] * inv_freq; const double ad = (double)ang;
        const double n = rint(ad * 0.15915494309189535); double rr = fma(-n, 6.283185307179586, ad); rr = fma(-n, 2.4492935982947064e-16, rr);
        double s, c; sincos_reduced(rr, s, c); P.COS[i] = (float)c; P.SIN[i] = (float)s; }
}


__device__ __forceinline__ void ln_phase(const float* xin, const float* __restrict__ ys, const float* __restrict__ g, const float* __restrict__ bta, float* out, bf16_t* __restrict__ outb, int tid_in) {
    int tid_ = tid_in; asm volatile("" : "+v"(tid_));
    const int lane = tid_ & 63, gw = blockIdx.x * 8 + (tid_ >> 6), NGW = gridDim.x * 8;
    f32x4 gg[4], bb[4];
#pragma unroll
    for (int j = 0; j < 4; ++j) { gg[j] = *(const f32x4*)(g + j * 256 + lane * 4); bb[j] = *(const f32x4*)(bta + j * 256 + lane * 4); }
    for (int row = gw; row < T; row += NGW) {
        f32x4 v[4]; float s = 0.f;
#pragma unroll
        for (int j = 0; j < 4; ++j) { const f32x4 x4 = *(const f32x4*)(xin + (size_t)row * DM + j * 256 + lane * 4), y4 = *(const f32x4*)(ys + (size_t)row * DM + j * 256 + lane * 4); v[j] = x4 * ALPHA + y4; s += (v[j][0] + v[j][1]) + (v[j][2] + v[j][3]); }
        const float mean = wave_sum(s) * (1.f / DM); float s2 = 0.f;
#pragma unroll
        for (int j = 0; j < 4; ++j) { v[j] = v[j] - mean; s2 += (v[j][0] * v[j][0] + v[j][1] * v[j][1]) + (v[j][2] * v[j][2] + v[j][3] * v[j][3]); }
        const float rstd = rsqrtf(wave_sum(s2) * (1.f / DM) + LN_EPS);
#pragma unroll
        for (int j = 0; j < 4; ++j) { const int c = j * 256 + lane * 4; const f32x4 o = v[j] * rstd * gg[j] + bb[j];
            *(f32x4*)(out + (size_t)row * DM + c) = o; uint2 w; w.x = pk2(o[0], o[1]); w.y = pk2(o[2], o[3]); *(uint2*)(outb + (size_t)row * DM + c) = w; }
    }
}
__device__ __forceinline__ void pool_phase(const float* __restrict__ X, bf16_t* __restrict__ PB, int tid_in) {
    int tid_ = tid_in; asm volatile("" : "+v"(tid_));
    const size_t gt = (size_t)blockIdx.x * MK_THREADS + tid_, NGT = (size_t)gridDim.x * MK_THREADS;
    for (size_t i = gt; i < (size_t)T * DM / 4; i += NGT) {
        const int row = (int)(i >> 8), c4 = (int)(i & 255), s = row & (SEQ - 1), w = 2 << (c4 >> 6), cnt = (s + 1 < w) ? s + 1 : w;
        const f32x4 x0 = *(const f32x4*)(X + (size_t)row * DM + c4 * 4); f32x4 sum = x0;
        for (int j = 1; j < cnt; ++j) sum = sum + *(const f32x4*)(X + (size_t)(row - j) * DM + c4 * 4);
        const f32x4 o = sum * (1.f / (float)cnt) - x0;
        uint2 wv; wv.x = pk2(o[0], o[1]); wv.y = pk2(o[2], o[3]); *(uint2*)(PB + (size_t)row * DM + c4 * 4) = wv;
    }
}

namespace att {
constexpr int DK = 192, DV = 128, NW = 8, QBLK = 32, KVBLK = 64, QB = NW * QBLK;
constexpr int LQ = 768, LKN = 1024, LKR = 64, LV = 1024, LO = 1024;
constexpr int SHM_V = KVBLK * DV * 2, SHM_K = KVBLK * DK * 2;
constexpr int LDS_BYTES = 2 * SHM_V + 2 * SHM_K + NW * 64 * 4;
constexpr float SCALE = 0.07216878364870322f;
constexpr float THR = 8.f;
typedef short s16x4 __attribute__((ext_vector_type(4)));
typedef float f32x16 __attribute__((ext_vector_type(16)));
typedef unsigned u32x4 __attribute__((ext_vector_type(4)));
#define KSWZ(row, colB) ((row) * 384 + ((colB) ^ (((row) & 7) << 4)))
#define SBAR() __builtin_amdgcn_sched_barrier(0)
__device__ __forceinline__ int v_st(int k, int c) { const int kk = (k & ~0xC) | ((k & 4) << 1) | ((k & 8) >> 1); return ((kk >> 3) * 4 + (c >> 5)) * 512 + ((kk & 7) * 32 + (c & 31)) * 2; }
__device__ __forceinline__ int v_rd_base(int lane) { return ((lane & 3) << 3) | (((lane >> 2) & 3) << 6) | (((lane >> 4) & 1) << 5) | (((lane >> 5) & 1) << 8); }
constexpr int v_rd_off(int d0, int ks, int half) { return d0 * 512 + ks * 4096 + half * 2048; }
__device__ __forceinline__ int crow(int r, int hi) { return (r & 3) + 8 * (r >> 2) + 4 * hi; }
__device__ __forceinline__ unsigned cvtpk(float lo, float hi) { unsigned r; asm volatile("v_cvt_pk_bf16_f32 %0, %1, %2" : "=v"(r) : "v"(lo), "v"(hi)); return r; }
__device__ __forceinline__ bf16x8 load8(const bf16_t* p) { return *reinterpret_cast<const bf16x8*>(p); }
__device__ __forceinline__ void mask_tile(f32x16& p0, f32x16& p1, int dq) {
    const float NEG = -__builtin_inff();
#pragma unroll
    for (int r = 0; r < 16; ++r) { const int c = (r & 3) + 8 * (r >> 2); if (dq - c < 0) p0[r] = NEG; if (dq - c - 32 < 0) p1[r] = NEG; }
}
__device__ __forceinline__ void partialSM(f32x16& p0, f32x16& p1, float& m_reg, float& mn, float& alpha) {
    float pmax = p0[0];
#pragma unroll
    for (int r = 1; r < 16; ++r) pmax = fmaxf(pmax, p0[r]);
#pragma unroll
    for (int r = 0; r < 16; ++r) pmax = fmaxf(pmax, p1[r]);
    { auto rr = __builtin_amdgcn_permlane32_swap(__float_as_uint(pmax), __float_as_uint(pmax), false, false); pmax = fmaxf(__uint_as_float(rr[0]), __uint_as_float(rr[1])); }
    constexpr float C2 = 1.4426950408889634f * SCALE;
    if (__builtin_expect(__all((pmax - m_reg) * SCALE <= THR), 1)) { mn = m_reg; alpha = 1.f; }
    else { mn = fmaxf(m_reg, pmax); alpha = __builtin_amdgcn_exp2f((m_reg - mn) * C2); m_reg = mn; }
    const float mnL = -mn * C2;
#pragma unroll
    for (int r = 0; r < 16; ++r) p0[r] = fmaf(p0[r], C2, mnL);
#pragma unroll
    for (int r = 0; r < 16; ++r) p1[r] = fmaf(p1[r], C2, mnL);
#pragma unroll
    for (int r = 0; r < 16; ++r) p0[r] = __builtin_amdgcn_exp2f(p0[r]);
}
__device__ __forceinline__ void finishSM(f32x16& p0, f32x16& p1, float alpha, float& l_reg, bf16x8& pa0, bf16x8& pa1, bf16x8& pa2, bf16x8& pa3) {
#pragma unroll
    for (int r = 0; r < 16; ++r) p1[r] = __builtin_amdgcn_exp2f(p1[r]);
    float ps = 0;
#pragma unroll
    for (int r = 0; r < 16; ++r) ps += p0[r];
#pragma unroll
    for (int r = 0; r < 16; ++r) ps += p1[r];
    { auto rr = __builtin_amdgcn_permlane32_swap(__float_as_uint(ps), __float_as_uint(ps), false, false); ps = __uint_as_float(rr[0]) + __uint_as_float(rr[1]); }
    l_reg = l_reg * alpha + ps;
#define PK4(P, B_, OUT) do { unsigned a0 = cvtpk(P[B_+0], P[B_+1]), a1 = cvtpk(P[B_+2], P[B_+3]);                          \
        unsigned b0 = cvtpk(P[B_+4], P[B_+5]), b1 = cvtpk(P[B_+6], P[B_+7]);                                             \
        auto r0 = __builtin_amdgcn_permlane32_swap(a0, b0, false, false); auto r1 = __builtin_amdgcn_permlane32_swap(a1, b1, false, false); \
        u32x4 w = {r0[0], r1[0], r0[1], r1[1]}; OUT = *reinterpret_cast<bf16x8*>(&w); } while (0)
    PK4(p0, 0, pa0); PK4(p0, 8, pa1); PK4(p1, 0, pa2); PK4(p1, 8, pa3);
#undef PK4
}
template <int KB>
__device__ __forceinline__ void qkt(f32x16& p0, f32x16& p1, const char* K_lds, int r32, int hi, const bf16x8* qr) {
    p0 = f32x16{}; p1 = f32x16{};
    const char* kb[4];
#pragma unroll
    for (int dd = 0; dd < 4; ++dd) kb[dd] = K_lds + KB * SHM_K + KSWZ(r32, (dd * 16 + hi * 8) * 2);
#pragma unroll
    for (int d0 = 0; d0 < 12; ++d0) { const char* a = kb[d0 & 3] + (d0 >> 2) * 128;
        bf16x8 b0 = *reinterpret_cast<const bf16x8*>(a);
        bf16x8 b1 = *reinterpret_cast<const bf16x8*>(a + 32 * 384);
        p0 = __builtin_amdgcn_mfma_f32_32x32x16_bf16(b0, qr[d0], p0, 0, 0, 0);
        p1 = __builtin_amdgcn_mfma_f32_32x32x16_bf16(b1, qr[d0], p1, 0, 0, 0); }
}
template <int VB>
__device__ __forceinline__ void pv_tile(f32x16* o, int vb0, bf16x8 pa0, bf16x8 pa1, bf16x8 pa2, bf16x8 pa3) {
#define TRRD(dst, off) asm volatile("ds_read_b64_tr_b16 %0, %1 offset:%2" : "=&v"(dst) : "v"(vb0), "i"(off) : "memory")
#define PV_D0(d0) do { s16x4 l0, l1, l2, l3, h0, h1, h2, h3; constexpr int b_ = VB * SHM_V + v_rd_off(d0, 0, 0); \
        TRRD(l0, b_); TRRD(h0, b_ + 2048); TRRD(l1, b_ + 4096); TRRD(h1, b_ + 6144); TRRD(l2, b_ + 8192); TRRD(h2, b_ + 10240); TRRD(l3, b_ + 12288); TRRD(h3, b_ + 14336); \
        asm volatile("s_waitcnt lgkmcnt(0)" ::: "memory"); SBAR();   \
        o[d0] = __builtin_amdgcn_mfma_f32_32x32x16_bf16(pa0, (bf16x8){l0[0], l0[1], l0[2], l0[3], h0[0], h0[1], h0[2], h0[3]}, o[d0], 0, 0, 0);   \
        o[d0] = __builtin_amdgcn_mfma_f32_32x32x16_bf16(pa1, (bf16x8){l1[0], l1[1], l1[2], l1[3], h1[0], h1[1], h1[2], h1[3]}, o[d0], 0, 0, 0);   \
        o[d0] = __builtin_amdgcn_mfma_f32_32x32x16_bf16(pa2, (bf16x8){l2[0], l2[1], l2[2], l2[3], h2[0], h2[1], h2[2], h2[3]}, o[d0], 0, 0, 0);   \
        o[d0] = __builtin_amdgcn_mfma_f32_32x32x16_bf16(pa3, (bf16x8){l3[0], l3[1], l3[2], l3[3], h3[0], h3[1], h3[2], h3[3]}, o[d0], 0, 0, 0); } while (0)
    PV_D0(0); PV_D0(1); PV_D0(2); PV_D0(3);
#undef PV_D0
#undef TRRD
}
struct BlockRef { const bf16_t* Q; const bf16_t* Kn; const bf16_t* Kr; const bf16_t* V; bf16_t* O; int P0; };
#define VMW() asm volatile("s_waitcnt vmcnt(0)" ::: "memory")
#define SLOAD_H(R_, k0) do { st_v0 = load8((R_).V + (size_t)((k0) + sr) * LV + sc); st_v1 = load8((R_).V + (size_t)((k0) + 32 + sr) * LV + sc);              \
                             st_k0 = load8((R_).Kn + (size_t)((k0) + sr) * LKN + sc); st_k1 = load8((R_).Kn + (size_t)((k0) + 32 + sr) * LKN + sc); \
                             st_k2 = load8((R_).Kr + (size_t)((k0) + rr_) * LKR + 8 * cr_); } while (0)
#define SWRITE_H(bf) do { *(bf16x8*)(V_lds + (bf) * SHM_V + vst0) = st_v0; *(bf16x8*)(V_lds + (bf) * SHM_V + vst1) = st_v1; \
                          *(bf16x8*)(K_lds + (bf) * SHM_K + kws) = st_k0; *(bf16x8*)(K_lds + (bf) * SHM_K + kws + 32 * 384) = st_k1; *(bf16x8*)(K_lds + (bf) * SHM_K + kwr) = st_k2; } while (0)
__device__ __forceinline__ void attn_block(const BlockRef& cur, char* lds, int tid_in) {
    int tid_ = tid_in; asm volatile("" : "+v"(tid_));
    const int tid = tid_, wid = __builtin_amdgcn_readfirstlane(tid >> 6), lane = tid & 63, r32 = lane & 31, hi = lane >> 5;
    const int NT = (cur.P0 + QB - 1) / KVBLK + 1;
    const int qlo = cur.P0 + wid * QBLK, qm = qlo + r32 - 4 * hi;
    char* V_lds = lds; char* K_lds = lds + 2 * SHM_V;
    float* ws = (float*)(lds + 2 * SHM_V + 2 * SHM_K) + wid * 64; float* li_l = ws, * al_l = ws + 32;
    float m_reg = -1e30f, l_reg = 0; f32x16 o[4] = {};
    const int sr = tid >> 4, sc = (tid & 15) * 8, rr_ = tid >> 3, cr_ = tid & 7, vst0 = v_st(sr, sc), vst1 = v_st(32 + sr, sc), kws = KSWZ(sr, sc * 2), kwr = KSWZ(rr_, 256 + 16 * cr_);
    const int vb0 = (int)(uintptr_t)V_lds + v_rd_base(lane);
    bf16x8 qr[12]; bf16x8 st_v0, st_v1, st_k0, st_k1, st_k2;
#pragma unroll
    for (int d0 = 0; d0 < 12; ++d0) qr[d0] = load8(cur.Q + (size_t)(wid * QBLK + r32) * LQ + d0 * 16 + hi * 8);
    SLOAD_H(cur, 0); VMW(); SWRITE_H(0);
    __syncthreads();
#define STEP(t, BUF) do { f32x16 p0, p1; float mn, alpha; bf16x8 pa0, pa1, pa2, pa3;                                         \
        if ((t) + 1 < NT) { SLOAD_H(cur, ((t) + 1) * KVBLK); SBAR(); }                                                           \
        qkt<BUF>(p0, p1, K_lds, r32, hi, qr);                                                                                  \
        { const int kb_ = (t) * KVBLK; if (kb_ + KVBLK - 1 > qlo) mask_tile(p0, p1, qm - kb_); }                                \
        partialSM(p0, p1, m_reg, mn, alpha); finishSM(p0, p1, alpha, l_reg, pa0, pa1, pa2, pa3);                                \
        if (__any(alpha < 1.f)) { if (hi == 0) al_l[r32] = alpha; asm volatile("s_waitcnt lgkmcnt(0)" ::: "memory");            \
            for (int d_ = 0; d_ < 4; ++d_) for (int r = 0; r < 16; ++r) o[d_][r] *= al_l[crow(r, hi)]; }                          \
        SBAR(); pv_tile<BUF>(o, vb0, pa0, pa1, pa2, pa3);                                                                       \
        if ((t) + 1 < NT) { VMW(); SWRITE_H((BUF) ^ 1); }                                                                        \
        __syncthreads(); } while (0)
    for (int t = 0; t < NT; t += 2) { STEP(t, 0); STEP(t + 1, 1); }
#undef STEP
    if (hi == 0) li_l[r32] = l_reg; asm volatile("s_waitcnt lgkmcnt(0)" ::: "memory");
    float rli[16];
#pragma unroll
    for (int r = 0; r < 16; ++r) rli[r] = __builtin_amdgcn_rcpf(li_l[crow(r, hi)]);
    bf16_t* Ow = cur.O + (size_t)(wid * QBLK) * LO;
#pragma unroll
    for (int r = 0; r < 16; ++r) { const int orow = crow(r, hi);
#pragma unroll
        for (int d0 = 0; d0 < 4; ++d0) { const float v = o[d0][r] * rli[r]; const float vn = __shfl_xor(v, 1);
            if ((r32 & 1) == 0) *(unsigned*)(Ow + (size_t)orow * LO + d0 * 32 + r32) = cvtpk(v, vn); } }
    __syncthreads();
}
#undef VMW
#undef SLOAD_H
#undef SWRITE_H
#undef KSWZ
#undef SBAR
__device__ __forceinline__ BlockRef block_ref(int bh, int qb, const bf16_t* QA, const bf16_t* KVB, const bf16_t* KR, bf16_t* Y) {
    const int b = bh >> 2, h = bh & 3; const size_t row0 = (size_t)b * SEQ; BlockRef r;
    r.Q = QA + (row0 + (size_t)qb * QB) * LQ + h * DK; r.Kn = KVB + row0 * LKN + h * 256; r.Kr = KR + row0 * LKR; r.V = KVB + row0 * LV + h * 256 + 128;
    r.O = Y + (row0 + (size_t)qb * QB) * LO + 512 + h * DV; r.P0 = qb * QB; return r;
}
}
namespace mls {
constexpr int TILE = 16384, TAB0 = 131072;
constexpr int T_A = 0, T_M = 256, T_SC = 512, T_EM = 768, T_W = 1024, T_N = 1280, T_DEC = 1792, TABSZ = 2048;
constexpr int DN0 = TAB0 + 2 * TABSZ, SSQ0 = DN0 + 512, LDS_NEED = SSQ0 + 2048;
typedef short v4i16_t __attribute__((ext_vector_type(4)));
typedef float f32x16 __attribute__((ext_vector_type(16)));
typedef unsigned u32x2 __attribute__((ext_vector_type(2)));
typedef unsigned u32x4 __attribute__((ext_vector_type(4)));
__device__ __forceinline__ int OFF(int row, int ch) { return 256 * row + 16 * (ch ^ (((row & 3) << 2) | ((row >> 2) & 3))); }
__device__ __forceinline__ unsigned cvtpk(float lo, float hi) { unsigned r; asm volatile("v_cvt_pk_bf16_f32 %0, %1, %2" : "=v"(r) : "v"(lo), "v"(hi)); return r; }
__device__ __forceinline__ bf16x8 pack8r(const f32x16& x, int b0) { u32x4 w; w.x = cvtpk(x[b0], x[b0 + 1]); w.y = cvtpk(x[b0 + 2], x[b0 + 3]); w.z = cvtpk(x[b0 + 4], x[b0 + 5]); w.w = cvtpk(x[b0 + 6], x[b0 + 7]); return __builtin_bit_cast(bf16x8, w); }
__device__ __forceinline__ v4i16_t trr(LAS unsigned char* p) { return __builtin_amdgcn_ds_read_tr16_b64_v4i16((LAS v4i16_t*)p); }
__device__ __forceinline__ bf16x8 join8(v4i16_t a, v4i16_t b) { return (bf16x8){a[0], a[1], a[2], a[3], b[0], b[1], b[2], b[3]}; }

__device__ __forceinline__ void mlstm_unit(int b, int h, LAS unsigned char* lds, const bf16_t* __restrict__ H1, const float* __restrict__ GI, const float* __restrict__ GF, const float* __restrict__ normw, bf16_t* __restrict__ Y, int tid_in) {
    int tid_ = tid_in; asm volatile("" : "+v"(tid_));
    const int tid = tid_, wid = __builtin_amdgcn_readfirstlane(tid >> 6), lane = tid & 63, r32 = lane & 31, hi = lane >> 5;
    const size_t row0 = (size_t)b * SEQ;
    constexpr int NC = SEQ / 64;
    const int lt = tid - 256;
    float m_carry = 0.f; float n_reg0 = 0.f, n_reg1 = 0.f;
#define MLS_TAB(p) (lds + TAB0 + (p) * TABSZ)
#define MLS_LOAD_TILES(cn) do { const int pn_ = (cn) & 1; u32x4 tv[16];                                                               \
        _Pragma("unroll") for (int x = 0; x < 4; ++x) _Pragma("unroll") for (int i = 0; i < 4; ++i) { const int idx = lt + 256 * i, row = idx >> 4, ch = idx & 15; \
            tv[x * 4 + i] = *(const u32x4*)(H1 + (row0 + (size_t)(cn) * 64 + row) * 2048 + x * 512 + h * 128 + 8 * ch); }                                        \
        _Pragma("unroll") for (int x = 0; x < 4; ++x) _Pragma("unroll") for (int i = 0; i < 4; ++i) { const int idx = lt + 256 * i, row = idx >> 4, ch = idx & 15; \
            *(LAS u32x4*)(lds + pn_ * 65536 + x * TILE + OFF(row, ch)) = tv[x * 4 + i]; } } while (0)
#define MLS_GATES(cn) do { const int pn_ = (cn) & 1; const size_t rw = row0 + (size_t)(cn) * 64 + lane;                                   \
        const float gi = GI[rw * 4 + h], gf = GF[rw * 4 + h];                                                                            \
        const float lf = fminf(gf, 0.f) - log1pf(__expf(-fabsf(gf)));                                                                     \
        float bb = lf;                                                                                                                    \
        _Pragma("unroll") for (int o = 1; o < 64; o <<= 1) { const float v_ = __shfl_up(bb, o); if (lane >= o) bb += v_; }               \
        const float aa = gi - bb; float mx = aa;                                                                                          \
        _Pragma("unroll") for (int o = 1; o < 64; o <<= 1) { const float v_ = __shfl_up(mx, o); if (lane >= o) mx = fmaxf(mx, v_); }      \
        const float Mv = fmaxf(mx, m_carry); const float M63 = __shfl(Mv, 63), b63 = __shfl(bb, 63);                                      \
        LAS float* tb_ = (LAS float*)MLS_TAB(pn_);                                                                                       \
        tb_[T_A / 4 + lane] = aa; tb_[T_M / 4 + lane] = Mv; tb_[T_SC / 4 + lane] = __expf(m_carry - Mv); tb_[T_EM / 4 + lane] = __expf(-(bb + Mv)); \
        tb_[T_W / 4 + lane] = __expf(aa - M63); if (lane == 0) tb_[T_DEC / 4] = __expf(m_carry - M63);                                    \
        m_carry = b63 + M63; } while (0)

    f32x16 X[4]; f32x16 hg[2]; float dint[2] = {0.f, 0.f}, sc_r[2] = {0.f, 0.f}, em_r[2] = {1.f, 1.f};
#pragma unroll
    for (int kb = 0; kb < 4; ++kb) X[kb] = f32x16{};
    hg[0] = f32x16{}; hg[1] = f32x16{};
    const int w = wid;
    const int g16 = (lane >> 4) & 1, q4 = (lane & 15) >> 2, p4 = lane & 3;
    if (wid >= 4) {
        MLS_LOAD_TILES(0);
        if (wid == 4) MLS_GATES(0);
        if (wid == 5) { LAS float* tb_ = (LAS float*)MLS_TAB(0); tb_[T_N / 4 + lane] = 0.f; tb_[T_N / 4 + 64 + lane] = 0.f; }
    }
    __syncthreads();
#pragma unroll 1
    for (int c = 0; c < NC; ++c) {
        const int p = c & 1;
        LAS unsigned char* Qt = lds + p * 65536; LAS unsigned char* Kt = Qt + TILE; LAS unsigned char* Vt = Qt + 2 * TILE; LAS unsigned char* Ot = Qt + 3 * TILE;
        LAS float* tab = (LAS float*)MLS_TAB(p);
        if (wid < 4) {
            if (c > 0) { const int pp = p ^ 1;
#pragma unroll
                for (int tb = 0; tb < 2; ++tb) { const int t = 32 * tb + r32;
                    const float den = dint[tb] + sc_r[tb] * ((LAS float*)(lds + DN0))[pp * 64 + t]; const float inv = 1.f / fmaxf(fabsf(den), em_r[tb]);
                    LAS float* sq = (LAS float*)(lds + SSQ0) + pp * 256 + t; const float ssq = ((sq[0] + sq[64]) + (sq[128] + sq[192])) * inv * inv;
                    const float scale = inv * rsqrtf(ssq * (1.f / 128.f) + RMS_EPS);
                    bf16_t* dst = Y + (row0 + (size_t)(c - 1) * 64 + t) * 1024 + h * 128 + 32 * w + 4 * hi;
#pragma unroll
                    for (int q = 0; q < 4; ++q) { u32x2 o2; o2.x = cvtpk(hg[tb][4 * q] * scale, hg[tb][4 * q + 1] * scale); o2.y = cvtpk(hg[tb][4 * q + 2] * scale, hg[tb][4 * q + 3] * scale); *(u32x2*)(dst + 8 * q) = o2; } } }
            __builtin_amdgcn_sched_barrier(0);
            sc_r[0] = tab[T_SC / 4 + r32]; sc_r[1] = tab[T_SC / 4 + 32 + r32]; em_r[0] = tab[T_EM / 4 + r32]; em_r[1] = tab[T_EM / 4 + 32 + r32];
            f32x16 acc[2]; acc[0] = f32x16{}; acc[1] = f32x16{};
#pragma unroll
            for (int kb = 0; kb < 4; ++kb)
#pragma unroll
                for (int s2 = 0; s2 < 2; ++s2) { const bf16x8 a = pack8r(X[kb], 8 * s2);
#pragma unroll
                    for (int tb = 0; tb < 2; ++tb) { const int t = 32 * tb + r32;
                        const v4i16_t lo = *(const LAS v4i16_t*)(Qt + OFF(t, 4 * kb + 2 * s2) + 8 * hi), hi8 = *(const LAS v4i16_t*)(Qt + OFF(t, 4 * kb + 2 * s2 + 1) + 8 * hi);
                        acc[tb] = __builtin_amdgcn_mfma_f32_32x32x16_bf16(a, join8(lo, hi8), acc[tb], 0, 0, 0); } }
#pragma unroll
            for (int tb = 0; tb < 2; ++tb)
#pragma unroll
                for (int r = 0; r < 16; ++r) acc[tb][r] *= sc_r[tb];
            __builtin_amdgcn_sched_barrier(0);
            float dsum[2] = {0.f, 0.f};
#pragma unroll
            for (int tl = 0; tl < 3; ++tl) { const int sb = tl >> 1, tb = (tl + 1) >> 1;
                f32x16 st = f32x16{};
#pragma unroll
                for (int ks = 0; ks < 8; ++ks) { const bf16x8 a = *(const LAS bf16x8*)(Kt + OFF(32 * sb + r32, 2 * ks + hi)), bq = *(const LAS bf16x8*)(Qt + OFF(32 * tb + r32, 2 * ks + hi));
                    st = __builtin_amdgcn_mfma_f32_32x32x16_bf16(a, bq, st, 0, 0, 0); }
                const float Mt = tab[T_M / 4 + 32 * tb + r32];
#pragma unroll
                for (int q = 0; q < 4; ++q) { const f32x4 a4 = *(const LAS f32x4*)(tab + T_A / 4 + 32 * sb + 8 * q + 4 * hi);
#pragma unroll
                    for (int i = 0; i < 4; ++i) { float e = __expf(a4[i] - Mt); if (sb == tb && (8 * q + 4 * hi + i) > r32) e = 0.f; const float v = st[4 * q + i] * e; st[4 * q + i] = v; dsum[tb] += v; } }
#pragma unroll
                for (int ks = 0; ks < 2; ++ks) { const int s0 = 32 * sb + 16 * ks + 4 * hi;
                    const v4i16_t lo = trr(Vt + OFF(s0 + q4, 4 * w + 2 * g16 + (p4 >> 1)) + 8 * (p4 & 1)), hi8 = trr(Vt + OFF(s0 + 8 + q4, 4 * w + 2 * g16 + (p4 >> 1)) + 8 * (p4 & 1));
                    acc[tb] = __builtin_amdgcn_mfma_f32_32x32x16_bf16(join8(lo, hi8), pack8r(st, 8 * ks), acc[tb], 0, 0, 0); } }
#pragma unroll
            for (int tb = 0; tb < 2; ++tb) { dsum[tb] += __shfl_xor(dsum[tb], 32); dint[tb] = dsum[tb]; }
            __builtin_amdgcn_sched_barrier(0);
#pragma unroll
            for (int tb = 0; tb < 2; ++tb) { const int t = 32 * tb + r32; float ss = 0.f;
#pragma unroll
                for (int r = 0; r < 16; ++r) ss += acc[tb][r] * acc[tb][r];
                ss += __shfl_xor(ss, 32);
                if (hi == 0) ((LAS float*)(lds + SSQ0))[p * 256 + w * 64 + t] = ss;
#pragma unroll
                for (int q = 0; q < 4; ++q) { const u32x2 ov = *(const LAS u32x2*)(Ot + OFF(t, 4 * w + q) + 8 * hi);
                    const float o0 = __builtin_bit_cast(float, ov.x << 16), o1 = __builtin_bit_cast(float, ov.x & 0xffff0000u), o2 = __builtin_bit_cast(float, ov.y << 16), o3 = __builtin_bit_cast(float, ov.y & 0xffff0000u);
                    const f32x4 nw4 = *(const f32x4*)(normw + h * 128 + 32 * w + 8 * q + 4 * hi);
                    hg[tb][4 * q] = acc[tb][4 * q] * sigmoidf_(o0) * nw4[0]; hg[tb][4 * q + 1] = acc[tb][4 * q + 1] * sigmoidf_(o1) * nw4[1];
                    hg[tb][4 * q + 2] = acc[tb][4 * q + 2] * sigmoidf_(o2) * nw4[2]; hg[tb][4 * q + 3] = acc[tb][4 * q + 3] * sigmoidf_(o3) * nw4[3]; } }
            __builtin_amdgcn_sched_barrier(0);
            const float dec = tab[T_DEC / 4];
#pragma unroll
            for (int kb = 0; kb < 4; ++kb)
#pragma unroll
                for (int r = 0; r < 16; ++r) X[kb][r] *= dec;
#pragma unroll
            for (int ks = 0; ks < 4; ++ks) { const int s0 = 16 * ks + 8 * hi;
                const v4i16_t vlo = trr(Vt + OFF(s0 + q4, 4 * w + 2 * g16 + (p4 >> 1)) + 8 * (p4 & 1)), vhi = trr(Vt + OFF(s0 + 4 + q4, 4 * w + 2 * g16 + (p4 >> 1)) + 8 * (p4 & 1));
                const f32x4 w0 = *(const LAS f32x4*)(tab + T_W / 4 + s0), w1 = *(const LAS f32x4*)(tab + T_W / 4 + s0 + 4);
                u32x4 bwv;
                bwv.x = cvtpk(bf2f((bf16_t)vlo[0]) * w0[0], bf2f((bf16_t)vlo[1]) * w0[1]); bwv.y = cvtpk(bf2f((bf16_t)vlo[2]) * w0[2], bf2f((bf16_t)vlo[3]) * w0[3]);
                bwv.z = cvtpk(bf2f((bf16_t)vhi[0]) * w1[0], bf2f((bf16_t)vhi[1]) * w1[1]); bwv.w = cvtpk(bf2f((bf16_t)vhi[2]) * w1[2], bf2f((bf16_t)vhi[3]) * w1[3]);
                const bf16x8 bw = __builtin_bit_cast(bf16x8, bwv);
#pragma unroll
                for (int kb = 0; kb < 4; ++kb) {
                    const v4i16_t klo = trr(Kt + OFF(s0 + q4, 4 * kb + 2 * g16 + (p4 >> 1)) + 8 * (p4 & 1)), khi = trr(Kt + OFF(s0 + 4 + q4, 4 * kb + 2 * g16 + (p4 >> 1)) + 8 * (p4 & 1));
                    X[kb] = __builtin_amdgcn_mfma_f32_32x32x16_bf16(join8(klo, khi), bw, X[kb], 0, 0, 0); } }
        } else {
            if (c + 1 < NC) MLS_LOAD_TILES(c + 1);
            if (wid == 4) { if (c + 1 < NC) MLS_GATES(c + 1); }
            else if (wid == 5) {
                const float dec = tab[T_DEC / 4]; float a0 = 0.f, a1 = 0.f;
                for (int s = 0; s < 64; ++s) { const float ws_ = tab[T_W / 4 + s];
                    a0 += ws_ * bf2f(*(const LAS bf16_t*)(Kt + OFF(s, lane >> 3) + 2 * (lane & 7))); a1 += ws_ * bf2f(*(const LAS bf16_t*)(Kt + OFF(s, 8 + (lane >> 3)) + 2 * (lane & 7))); }
                n_reg0 = dec * n_reg0 + a0; n_reg1 = dec * n_reg1 + a1;
                LAS float* tn = (LAS float*)MLS_TAB(p ^ 1); tn[T_N / 4 + lane] = n_reg0; tn[T_N / 4 + 64 + lane] = n_reg1;
            } else if (wid == 6) {
                float d = 0.f;
#pragma unroll
                for (int ch = 0; ch < 16; ++ch) { const u32x4 qv = *(const LAS u32x4*)(Qt + OFF(lane, ch)); const f32x4 n0 = *(const LAS f32x4*)(tab + T_N / 4 + 8 * ch), n1 = *(const LAS f32x4*)(tab + T_N / 4 + 8 * ch + 4);
                    d += __builtin_bit_cast(float, qv.x << 16) * n0[0] + __builtin_bit_cast(float, qv.x & 0xffff0000u) * n0[1] + __builtin_bit_cast(float, qv.y << 16) * n0[2] + __builtin_bit_cast(float, qv.y & 0xffff0000u) * n0[3]
                       + __builtin_bit_cast(float, qv.z << 16) * n1[0] + __builtin_bit_cast(float, qv.z & 0xffff0000u) * n1[1] + __builtin_bit_cast(float, qv.w << 16) * n1[2] + __builtin_bit_cast(float, qv.w & 0xffff0000u) * n1[3]; }
                ((LAS float*)(lds + DN0))[p * 64 + lane] = d;
            }
        }
        __syncthreads();
    }
    if (wid < 4) {
        const int pp = (NC - 1) & 1;
#pragma unroll
        for (int tb = 0; tb < 2; ++tb) { const int t = 32 * tb + r32;
            const float den = dint[tb] + sc_r[tb] * ((LAS float*)(lds + DN0))[pp * 64 + t]; const float inv = 1.f / fmaxf(fabsf(den), em_r[tb]);
            LAS float* sq = (LAS float*)(lds + SSQ0) + pp * 256 + t; const float ssq = ((sq[0] + sq[64]) + (sq[128] + sq[192])) * inv * inv;
            const float scale = inv * rsqrtf(ssq * (1.f / 128.f) + RMS_EPS);
            bf16_t* dst = Y + (row0 + (size_t)(NC - 1) * 64 + t) * 1024 + h * 128 + 32 * w + 4 * hi;
#pragma unroll
            for (int q = 0; q < 4; ++q) { u32x2 o2; o2.x = cvtpk(hg[tb][4 * q] * scale, hg[tb][4 * q + 1] * scale); o2.y = cvtpk(hg[tb][4 * q + 2] * scale, hg[tb][4 * q + 3] * scale); *(u32x2*)(dst + 8 * q) = o2; } }
    }
    __syncthreads();
#undef MLS_TAB
#undef MLS_LOAD_TILES
#undef MLS_GATES
}
}
#include <hip/hip_cooperative_groups.h>
namespace cg = cooperative_groups;
__device__ __forceinline__ int lane_id_fresh() { int l; asm volatile("v_mbcnt_lo_u32_b32 %0, -1, 0\n\tv_mbcnt_hi_u32_b32 %0, -1, %0" : "=v"(l)); return l; }
__device__ __forceinline__ void mixer_phase(LAS unsigned char* lds, unsigned char* lds_generic, unsigned* qctr, const WsPtrs& P, const float* normw, int wave_s) {
    for (;;) {
        const int tid = wave_s * 64 + lane_id_fresh();
        if (tid == 0) *(volatile LAS unsigned*)(lds + MK_QWORD) = atomicAdd(qctr, 1u);
        __syncthreads();
        const unsigned it = *(volatile LAS unsigned*)(lds + MK_QWORD);
        __syncthreads();
        if (it >= 32u + 512u) break;
        if (it < 32u) mls::mlstm_unit((int)(it >> 2), (int)(it & 3), lds, P.H1, P.GI, P.GF, normw, P.Y, tid);
        else { const int j = (int)it - 32, qb = 15 - (j >> 5), bh = j & 31; att::attn_block(att::block_ref(bh, qb, P.QA, P.KVB, P.KR, P.Y), (char*)lds_generic, tid); }
    }
}

#define XB_TMO      128
#define XB_XCNT(j)  (256  + 64 * (j))
#define XB_XSUB(j)  (1280 + 64 * (j))
#define XB_XGEN(j)  (2304 + 64 * (j))
#define XB_TOP      3328
#define XB_TOPGEN   3392
#define XCD_BAR_WORDS 3456
#define XB_SPIN_CAP (1u << 20)
__device__ __forceinline__ unsigned xb_ld(unsigned* p)              { return __hip_atomic_load(p, __ATOMIC_RELAXED, __HIP_MEMORY_SCOPE_AGENT); }
__device__ __forceinline__ unsigned xb_add(unsigned* p, unsigned v) { return __hip_atomic_fetch_add(p, v, __ATOMIC_RELAXED, __HIP_MEMORY_SCOPE_AGENT); }
__device__ __forceinline__ unsigned xb_xcc_id() { return (unsigned)__builtin_amdgcn_s_getreg((3 << 11) | 20) & 0xFu; }
#define XB_SPIN(cond, bar) do { unsigned _sp = 0; while (cond) { __builtin_amdgcn_s_sleep(1); \
    if ((++_sp & 255u) == 0u) { if (xb_ld(&(bar)[XB_TMO])) break; if (_sp > XB_SPIN_CAP) { atomicAdd(&(bar)[XB_TMO], 1u); break; } } } } while (0)
__device__ __forceinline__ void xcd_barrier_complete(unsigned* bar, unsigned x, unsigned& nloc, unsigned& nx) {
    const unsigned G = gridDim.x * gridDim.y * gridDim.z;
    unsigned sum, cnt, mine, sp = 0u;
    for (;;) {
        sum = 0u; cnt = 0u; mine = 0u;
#pragma unroll
        for (unsigned j = 0; j < 16; ++j) { const unsigned c = xb_ld(&bar[XB_XCNT(j)]); sum += c; cnt += (c > 0u) ? 1u : 0u; mine = (j == x) ? c : mine; }
        if (sum == G) break;
        __builtin_amdgcn_s_sleep(1);
        if ((++sp & 255u) == 0u) { if (xb_ld(&bar[XB_TMO])) break; if (sp > XB_SPIN_CAP) { atomicAdd(&bar[XB_TMO], 1u); break; } }
    }
    nloc = mine > 0u ? mine : 1u; nx = cnt > 0u ? cnt : 1u;
}
__device__ __forceinline__ void xcd_barrier(unsigned* bar, volatile LAS unsigned* st, bool leader) {
    asm volatile("s_waitcnt vmcnt(0)" ::: "memory");
    __syncthreads();
    if (leader) {
        const unsigned x = xb_xcc_id();
        __builtin_amdgcn_s_waitcnt(0);
        unsigned nloc = st[0], nx = st[1];
        if (nloc == 0u) { xcd_barrier_complete(bar, x, nloc, nx); st[0] = nloc; st[1] = nx; }
        const unsigned old = xb_add(&bar[XB_XSUB(x)], 1u);
        const unsigned gen = old / nloc;
        if (old + 1u == (gen + 1u) * nloc) {
            __builtin_amdgcn_fence(__ATOMIC_RELEASE, "agent");
            asm volatile("s_waitcnt vmcnt(0)" ::: "memory");
            const unsigned og = xb_add(&bar[XB_TOP], 1u);
            const unsigned tg = og / nx;
            if (og + 1u == (tg + 1u) * nx) xb_add(&bar[XB_TOPGEN], 1u);
            else XB_SPIN(xb_ld(&bar[XB_TOPGEN]) == tg, bar);
            __builtin_amdgcn_fence(__ATOMIC_ACQUIRE, "agent");
            xb_add(&bar[XB_XGEN(x)], 1u);
            asm volatile("s_waitcnt vmcnt(0)" ::: "memory");
        } else {
            XB_SPIN(xb_ld(&bar[XB_XGEN(x)]) == gen, bar);
            __builtin_amdgcn_fence(__ATOMIC_ACQUIRE, "agent");
            asm volatile("s_waitcnt vmcnt(0)" ::: "memory");
        }
    }
    __syncthreads();
}
constexpr int CW_BAR = 4096;
typedef __attribute__((address_space(4))) const Args* KArgs;
__device__ __forceinline__ Args kargs() {
#if defined(__HIP_DEVICE_COMPILE__)
    KArgs p = (KArgs)__builtin_amdgcn_kernarg_segment_ptr(); asm volatile("" : "+s"(p)); Args r; __builtin_memcpy(&r, p, sizeof(Args)); return r;
#else
    return Args{};
#endif
}
template <bool COOP>
__global__ void __launch_bounds__(MK_THREADS, 2) mk_fwd(Args a_unused) {
    extern __shared__ __attribute__((aligned(16))) unsigned char lds_raw[];
    LAS unsigned char* lds = (LAS unsigned char*)lds_raw;
    int lo, hi; { const Args a0 = kargs(); lo = a0.ph_lo; hi = a0.ph_hi; }
    const int G = gridDim.x;
    const int wave_s = __builtin_amdgcn_readfirstlane((int)threadIdx.x >> 6);
#define MK_TID() (wave_s * 64 + lane_id_fresh())
#define PH_ARGS const Args a = kargs(); const WsPtrs P = ws_ptrs(a.ws); (void)P
#define IN(k) (lo <= (k) && (k) < hi)
#define SYNC(k) do { if constexpr (COOP) { if (IN(k) && IN((k) + 1)) { \
        if ((k) == 0) { cg::this_grid().sync();     \
            const Args a_ = kargs(); if (MK_TID() == 0) (void)xb_add((unsigned*)(a_.ws + WS_CTL) + CW_BAR + XB_XCNT(xb_xcc_id()), 1u); } \
        else { const Args a_ = kargs(); xcd_barrier((unsigned*)(a_.ws + WS_CTL) + CW_BAR, (volatile LAS unsigned*)(lds + MK_QWORD + 8), MK_TID() == 0); } } } } while (0)
    { const int t0 = MK_TID(); if (t0 < 4) ((LAS unsigned*)(lds + MK_QWORD))[t0] = 0u; }
    __syncthreads();
    if (IN(0)) { PH_ARGS; if (blockIdx.x == 0) { const int t0 = MK_TID(); unsigned* ctl = (unsigned*)(a.ws + WS_CTL); if (t0 == 0) ctl[0] = 0u; for (int i = t0; i < XCD_BAR_WORDS; i += MK_THREADS) ctl[CW_BAR + i] = 0u; }
        p0_prologue(a, P, lds, MK_TID()); __syncthreads(); }
    SYNC(0);
    if (IN(1)) { PH_ARGS;
        pg8::Gemm g{P.XNB, P.Win_t, DM, DM, DM, 0}; pg8::StaticOrder S; S.init(T / 256, NIN / 256, G, (int)blockIdx.x);
        pg8::EpiWin E{P.H1, P.CQ, P.CKV, P.KR, P.SSQ, P.GI, P.GF, P.COS, P.SIN, (const float*)a.in[3], (const float*)a.in[4]};
        pg8::gemm_phase<pg8::EpiWin, pg8::StaticOrder, pg8::AMapStd, true, true>(lds, g, S, E, MK_TID());
    }
    SYNC(1);
    if (IN(2)) { PH_ARGS;
        { pg8::Gemm g{P.CQ, P.Wuq_t, 256, 256, 256, 0}; pg8::StaticOrder S; S.init(T / 256, 3, G, (int)blockIdx.x);
          pg8::EpiUq E{P.QA, P.SSQ, P.COS, P.SIN};
          pg8::gemm_phase<pg8::EpiUq, pg8::StaticOrder, pg8::AMapStd, true, true>(lds, g, S, E, MK_TID()); }
        { pg8::Gemm g{P.CKV, P.Wukv_t, 128, 128, 128, 0}; pg8::StaticOrder S; S.init(T / 256, 4, G, (int)blockIdx.x);
          pg8::EpiUkv E{P.KVB, P.SSQ};
          pg8::gemm_phase<pg8::EpiUkv, pg8::StaticOrder, pg8::AMapStd, true, true>(lds, g, S, E, MK_TID()); }
    }
    SYNC(2);
    if (IN(3)) { PH_ARGS; mixer_phase(lds, lds_raw, (unsigned*)(a.ws + WS_CTL), P, (const float*)a.in[5], wave_s); }
    SYNC(3);
    if (IN(4)) { PH_ARGS;
        pg8::Gemm g{P.Y, P.Wout_t, DM, DM, DM, 0}; pg8::StaticOrder S; S.init(T / 256, 4, G, (int)blockIdx.x);
        pg8::EpiF32 E{(float*)(a.ws + WS_YS_A), nullptr, DM, 0};
        pg8::gemm_phase<pg8::EpiF32, pg8::StaticOrder, pg8::AMapStd, true, true>(lds, g, S, E, MK_TID());
    }
    SYNC(4);
    if (IN(5)) { PH_ARGS; ln_phase((const float*)a.in[0], (const float*)(a.ws + WS_YS_A), (const float*)a.in[17], (const float*)a.in[18], a.out, P.XNB, MK_TID()); }
    SYNC(5);
#pragma unroll 1
    for (int l = 0; l < 2; ++l) {
        const int pb = 6 + 6 * l;
        if (l == 1) {
            if (IN(9)) { PH_ARGS; pool_phase(a.out, (bf16_t*)(a.ws + WS_PB), MK_TID()); }
            SYNC(9);
            if (IN(10)) { PH_ARGS; pg8::Gemm g{(const bf16_t*)(a.ws + WS_PB), P.Wpool_t, 256, DM, 256, 512}; pg8::StaticOrder S; S.init(T / 256, 4, G, (int)blockIdx.x);
                pg8::EpiF32 E{(float*)(a.ws + WS_YS_C), (const float*)a.in[12], DM, 0};
                pg8::gemm_phase<pg8::EpiF32, pg8::StaticOrder, pg8::AMapStd, true, true>(lds, g, S, E, MK_TID()); }
            SYNC(10);
            if (IN(11)) { PH_ARGS; ln_phase(a.out, (const float*)(a.ws + WS_YS_C), (const float*)a.in[17] + DM, (const float*)a.in[18] + DM, a.out, P.XNB, MK_TID()); }
            SYNC(11);
        }
        if (IN(pb)) { PH_ARGS;
            pg8::Gemm g{P.XNB, P.Wup_t + (size_t)l * FF2 * DM, DM, DM, DM, 0}; pg8::StaticOrder S; S.init(131, 22, G, (int)blockIdx.x);
            pg8::EpiConv E{(bf16_t*)(a.ws + WS_G), (const float*)a.in[14] + (size_t)l * 3 * FF2, (const float*)a.in[15] + (size_t)l * FF2};
            pg8::gemm_phase<pg8::EpiConv, pg8::StaticOrder, pg8::AMapConv, true, true>(lds, g, S, E, MK_TID());
        }
        SYNC(pb);
        if (IN(pb + 1)) { PH_ARGS;
            pg8::Gemm g{(const bf16_t*)(a.ws + WS_G), P.Wdn_t + (size_t)l * DM * FF, FF, FF, FF, 0}; pg8::StaticOrder S; S.init(T / 256, 4, G, (int)blockIdx.x);
            pg8::EpiF32 E{(float*)(a.ws + WS_YS_B), nullptr, DM, 0};
            pg8::gemm_phase<pg8::EpiF32, pg8::StaticOrder, pg8::AMapStd, true, true>(lds, g, S, E, MK_TID());
        }
        SYNC(pb + 1);
        if (IN(pb + 2)) { PH_ARGS; ln_phase(a.out, (const float*)(a.ws + WS_YS_B), (const float*)a.in[19] + (size_t)l * DM, (const float*)a.in[20] + (size_t)l * DM, a.out, P.XNB, MK_TID()); }
        SYNC(pb + 2);
    }
#undef IN
#undef SYNC
#undef PH_ARGS
#undef MK_TID
}
constexpr int N_PHASES = 18;

#ifndef MK_ONE_LAUNCH
#define MK_ONE_LAUNCH 1
#endif
extern "C" void kernel_launch(void* const* d_in, const int* in_sizes, int n_in, void* d_out, int out_size, void* d_ws, size_t ws_size, hipStream_t stream) {
    if (n_in != 21 || in_sizes[0] != T * DM || out_size != T * DM || ws_size < WS_END) { fprintf(stderr, "kernel_launch: unexpected shapes (n_in %d, in0 %d, out %d, ws %zu)\n", n_in, n_in > 0 ? in_sizes[0] : -1, out_size, ws_size); return; }
    static int grid = 0;
    if (grid == 0) {
        int dev = 0, cus = 0, per_cu = 0;
        (void)hipGetDevice(&dev); (void)hipDeviceGetAttribute(&cus, hipDeviceAttributeMultiprocessorCount, dev);
        hipError_t e = hipFuncSetAttribute((const void*)mk_fwd<(MK_ONE_LAUNCH != 0)>, hipFuncAttributeMaxDynamicSharedMemorySize, MK_LDS);
        if (e != hipSuccess) fprintf(stderr, "kernel_launch: hipFuncSetAttribute: %s\n", hipGetErrorString(e));
        e = hipOccupancyMaxActiveBlocksPerMultiprocessor(&per_cu, (const void*)mk_fwd<(MK_ONE_LAUNCH != 0)>, MK_THREADS, MK_LDS);
        if (e != hipSuccess || per_cu < 1) { fprintf(stderr, "kernel_launch: occupancy query: %s (%d per CU)\n", hipGetErrorString(e), per_cu); per_cu = 1; }
        (void)hipGetLastError();
        grid = (cus > 0 ? cus : 256) * 1;
    }
    Args a{}; for (int i = 0; i < 21; ++i) a.in[i] = d_in[i]; a.out = (float*)d_out; a.ws = (unsigned char*)d_ws;
#if MK_ONE_LAUNCH
    a.ph_lo = 0; a.ph_hi = 15;
    void* args[] = {&a};
    hipError_t e = hipLaunchCooperativeKernel((const void*)mk_fwd<true>, dim3(grid), dim3(MK_THREADS), args, MK_LDS, stream);
    if (e != hipSuccess) fprintf(stderr, "kernel_launch: cooperative launch failed: %s (grid %d)\n", hipGetErrorString(e), grid);
#else
    for (int ph = 0; ph < 15; ++ph) { a.ph_lo = ph; a.ph_hi = ph + 1; mk_fwd<false><<<dim3(grid), dim3(MK_THREADS), MK_LDS, stream>>>(a); }
#endif
}
```
